# Optimizing an MI355X kernel written in HIP

```python
import math, functools
import jax, jax.numpy as jnp
from jax import lax
import numpy as np

D_MODEL = 1024
BATCH = 8
SEQ = 4096
DEPTH = 2
DEC_BATCH = 128
DEC_SEQ = 4
PAST_LEN = 16384
PAGE_SIZE = 128

ATTN_WIDTH = D_MODEL // 2
SSM_WIDTH = D_MODEL - ATTN_WIDTH
HEAD_DIM = 64
N_HEADS = ATTN_WIDTH // HEAD_DIM
N_KV_HEADS = 2
GQA_GROUP = N_HEADS // N_KV_HEADS
KV_WIDTH = N_KV_HEADS * HEAD_DIM
WINDOW = 128
BLOCK = WINDOW
GROUP_CH = 16
N_GROUPS = SSM_WIDTH // GROUP_CH
STATE = 64
IN_WIDTH = ATTN_WIDTH + 2 * KV_WIDTH + SSM_WIDTH
D_FF = 2688
CONV_W = 3
EPS = 1e-5
DT_MIN = 1e-3
DT_MAX = 1e-1
MASK_VALUE = -1e30

kernel_name = "hymba_swa_s5_convffn_step"


def _rmsnorm(x, g):
    xf = x.astype(jnp.float32)
    y = xf * lax.rsqrt(jnp.mean(xf * xf, axis=-1, keepdims=True) + EPS)
    return (y * g.astype(jnp.float32)).astype(x.dtype)


def _alibi_slopes():
    h = jnp.arange(1, N_HEADS + 1, dtype=jnp.float32)
    return jnp.exp2(-8.0 * h / N_HEADS).reshape(N_KV_HEADS, GQA_GROUP)


def _sink_softmax(s, sink):
    sk = sink[:, :, None, None]
    m = jnp.maximum(jnp.max(s, axis=-1, keepdims=True), sk)
    e = jnp.exp(s - m)
    return e / (jnp.sum(e, axis=-1, keepdims=True) + jnp.exp(sk - m))


def _swa_prompt(q, k, v, sinks):
    b, L = q.shape[0], q.shape[1]
    nb = L // BLOCK
    scale = HEAD_DIM ** -0.5
    qb = q.reshape(b, nb, BLOCK, N_KV_HEADS, GQA_GROUP, HEAD_DIM)
    pad = jnp.zeros((b, BLOCK, N_KV_HEADS, HEAD_DIM), k.dtype)
    kb = jnp.concatenate([pad, k], axis=1).reshape(b, nb + 1, BLOCK, N_KV_HEADS, HEAD_DIM)
    vb = jnp.concatenate([pad.astype(v.dtype), v], axis=1).reshape(b, nb + 1, BLOCK, N_KV_HEADS, HEAD_DIM)
    kband = jnp.concatenate([kb[:, :-1], kb[:, 1:]], axis=2)
    vband = jnp.concatenate([vb[:, :-1], vb[:, 1:]], axis=2)
    s = jnp.einsum('bnqhgd,bnkhd->bnhgqk', qb, kband,
                   preferred_element_type=jnp.float32) * scale
    blk = jnp.arange(nb)[:, None] * BLOCK
    qpos = blk + jnp.arange(BLOCK)[None, :]
    kpos = blk - BLOCK + jnp.arange(2 * BLOCK)[None, :]
    dist = qpos[:, :, None] - kpos[:, None, :]
    valid = (dist >= 0) & (dist < WINDOW) & (kpos[:, None, :] >= 0)
    slopes = _alibi_slopes()
    s = s - slopes[None, None, :, :, None, None] * dist[None, :, None, None].astype(jnp.float32)
    s = jnp.where(valid[None, :, None, None], s, MASK_VALUE)
    p = _sink_softmax(s, sinks)
    o = jnp.einsum('bnhgqk,bnkhd->bnqhgd', p.astype(v.dtype), vband)
    w = min(WINDOW, L)
    return o.reshape(b, L, ATTN_WIDTH), k[:, -w:], v[:, -w:]


def _swa_sample(q, k, v, sinks, k_buf, v_buf):
    b, T = q.shape[0], q.shape[1]
    w = k_buf.shape[1]
    scale = HEAD_DIM ** -0.5
    kc = jnp.concatenate([k_buf.astype(k.dtype), k], axis=1)
    vc = jnp.concatenate([v_buf.astype(v.dtype), v], axis=1)
    qg = q.reshape(b, T, N_KV_HEADS, GQA_GROUP, HEAD_DIM)
    s = jnp.einsum('bqhgd,bkhd->bhgqk', qg, kc,
                   preferred_element_type=jnp.float32) * scale
    qpos = PAST_LEN + jnp.arange(T)
    kpos = jnp.concatenate([PAST_LEN - w + jnp.arange(w), PAST_LEN + jnp.arange(T)])
    dist = qpos[:, None] - kpos[None, :]
    valid = (dist >= 0) & (dist < WINDOW)
    slopes = _alibi_slopes()
    s = s - slopes[None, :, :, None, None] * dist[None, None, None].astype(jnp.float32)
    s = jnp.where(valid[None, None, None], s, MASK_VALUE)
    p = _sink_softmax(s, sinks)
    o = jnp.einsum('bhgqk,bkhd->bqhgd', p.astype(v.dtype), vc)
    return o.reshape(b, T, ATTN_WIDTH), kc[:, -w:], vc[:, -w:]


def _lin_combine(left, right):
    a1, b1 = left
    a2, b2 = right
    return a1 * a2, a2 * b1 + b2


def _s5(u, h0_re, h0_im, lam_re, lam_im, log_step, b_re, b_im, c_re, c_im, d_skip):
    f32 = jnp.float32
    b, L = u.shape[0], u.shape[1]
    ug = u.astype(f32).reshape(b, L, N_GROUPS, GROUP_CH)
    lam = lax.complex(lam_re.astype(f32), lam_im.astype(f32))
    dt = jnp.exp(log_step.astype(f32))[:, None]
    lam_bar = jnp.exp(lam * dt)
    b_bar = ((lam_bar - 1.0) / lam)[..., None] * lax.complex(b_re.astype(f32), b_im.astype(f32))
    bu = jnp.einsum('blgh,gnh->blgn', ug.astype(jnp.complex64), b_bar)
    a = jnp.broadcast_to(lam_bar, (1, L, N_GROUPS, STATE))
    a_cum, xs = lax.associative_scan(_lin_combine, (a, bu), axis=1)
    h0 = lax.complex(h0_re.astype(f32), h0_im.astype(f32))
    xs = xs + a_cum * h0[:, None]
    c = lax.complex(c_re.astype(f32), c_im.astype(f32))
    y = jnp.einsum('blgn,ghn->blgh', xs, c).real \
        + d_skip.astype(f32).reshape(N_GROUPS, GROUP_CH) * ug
    h_last = xs[:, -1]
    return y.reshape(b, L, SSM_WIDTH).astype(u.dtype), jnp.real(h_last), jnp.imag(h_last)


def _conv_ffn(h, prev, w_up, conv_w, conv_b, w_down):
    L = h.shape[1]
    up = h @ w_up
    buf = jnp.concatenate([prev.astype(up.dtype), up], axis=1)
    c = conv_b + sum(conv_w[i] * buf[:, i:i + L] for i in range(CONV_W))
    a, g = jnp.split(c, 2, axis=-1)
    return (jax.nn.silu(g) * a) @ w_down, buf[:, -(CONV_W - 1):]


def _layer(x, p, attend, h0_re, h0_im, conv_prev):
    b, L = x.shape[0], x.shape[1]
    h = _rmsnorm(x, p['norm_mix'])
    proj = h @ p['w_in']
    q = proj[..., :ATTN_WIDTH].reshape(b, L, N_HEADS, HEAD_DIM)
    k = proj[..., ATTN_WIDTH:ATTN_WIDTH + KV_WIDTH].reshape(b, L, N_KV_HEADS, HEAD_DIM)
    v = proj[..., ATTN_WIDTH + KV_WIDTH:ATTN_WIDTH + 2 * KV_WIDTH].reshape(b, L, N_KV_HEADS, HEAD_DIM)
    u = proj[..., ATTN_WIDTH + 2 * KV_WIDTH:]
    sinks = p['sinks'].astype(jnp.float32).reshape(N_KV_HEADS, GQA_GROUP)
    attn, k_win, v_win = attend(q, k, v, sinks)
    ssm, h_re, h_im = _s5(u, h0_re, h0_im, p['lam_re'], p['lam_im'], p['log_step'],
                          p['b_re'], p['b_im'], p['c_re'], p['c_im'], p['d_skip'])
    ssm = jax.nn.gelu(ssm)
    ssm = ssm * jax.nn.sigmoid(ssm @ p['w_glu'] + p['b_glu'])
    merged = jnp.concatenate([_rmsnorm(attn, p['g_attn']), _rmsnorm(ssm, p['g_ssm'])], axis=-1)
    x = x + merged @ p['w_out']
    f, conv_new = _conv_ffn(_rmsnorm(x, p['norm_ffn']), conv_prev,
                            p['w_up'], p['conv_w'], p['conv_b'], p['w_down'])
    x = x + f
    return x, (k_win, v_win, h_re, h_im, conv_new)


def setup_inputs(seed: int = 0) -> dict:
    key = jax.random.key(seed)
    ks = jax.random.split(key, 32)
    f32 = jnp.float32
    win_buf = min(WINDOW, PAST_LEN)

    def nrm(k, shape, scale):
        return jax.random.normal(k, shape, f32) * scale

    n_idx = jnp.arange(STATE, dtype=f32)
    lam_re = -0.5 + nrm(ks[10], (DEPTH, N_GROUPS, STATE), 0.01)
    lam_im = math.pi * n_idx[None, None, :] + nrm(ks[11], (DEPTH, N_GROUPS, STATE), 0.01)
    log_step = jax.random.uniform(ks[12], (DEPTH, N_GROUPS), f32,
                                  math.log(DT_MIN), math.log(DT_MAX))
    return {
        "x_prompt": nrm(ks[0], (BATCH, SEQ, D_MODEL), 1.0),
        "x_sample": nrm(ks[1], (DEC_BATCH, DEC_SEQ, D_MODEL), 1.0),
        "cache_k_win": nrm(ks[2], (DEPTH, DEC_BATCH, win_buf, N_KV_HEADS, HEAD_DIM), 1.0),
        "cache_v_win": nrm(ks[3], (DEPTH, DEC_BATCH, win_buf, N_KV_HEADS, HEAD_DIM), 1.0),
        "state_ssm_re": nrm(ks[4], (DEPTH, DEC_BATCH, N_GROUPS, STATE), 0.5),
        "state_ssm_im": nrm(ks[5], (DEPTH, DEC_BATCH, N_GROUPS, STATE), 0.5),
        "state_conv": nrm(ks[6], (DEPTH, DEC_BATCH, CONV_W - 1, 2 * D_FF), 1.0),
        "norm_mix": 1.0 + nrm(ks[7], (DEPTH, D_MODEL), 0.02),
        "w_in": nrm(ks[8], (DEPTH, D_MODEL, IN_WIDTH), D_MODEL ** -0.5),
        "sinks": nrm(ks[9], (DEPTH, N_HEADS), 0.5),
        "lam_re": lam_re,
        "lam_im": lam_im,
        "log_step": log_step,
        "b_re": nrm(ks[13], (DEPTH, N_GROUPS, STATE, GROUP_CH), (2 * GROUP_CH) ** -0.5),
        "b_im": nrm(ks[14], (DEPTH, N_GROUPS, STATE, GROUP_CH), (2 * GROUP_CH) ** -0.5),
        "c_re": nrm(ks[15], (DEPTH, N_GROUPS, GROUP_CH, STATE), (2 * STATE) ** -0.5),
        "c_im": nrm(ks[16], (DEPTH, N_GROUPS, GROUP_CH, STATE), (2 * STATE) ** -0.5),
        "d_skip": nrm(ks[17], (DEPTH, SSM_WIDTH), 1.0),
        "w_glu": nrm(ks[18], (DEPTH, SSM_WIDTH, SSM_WIDTH), SSM_WIDTH ** -0.5),
        "b_glu": nrm(ks[19], (DEPTH, SSM_WIDTH), 0.01),
        "g_attn": 1.0 + nrm(ks[20], (DEPTH, ATTN_WIDTH), 0.02),
        "g_ssm": 1.0 + nrm(ks[21], (DEPTH, SSM_WIDTH), 0.02),
        "w_out": nrm(ks[22], (DEPTH, ATTN_WIDTH + SSM_WIDTH, D_MODEL), (ATTN_WIDTH + SSM_WIDTH) ** -0.5),
        "norm_ffn": 1.0 + nrm(ks[23], (DEPTH, D_MODEL), 0.02),
        "w_up": nrm(ks[24], (DEPTH, D_MODEL, 2 * D_FF), D_MODEL ** -0.5),
        "conv_w": nrm(ks[25], (DEPTH, CONV_W, 2 * D_FF), CONV_W ** -0.5),
        "conv_b": nrm(ks[26], (DEPTH, 2 * D_FF), 0.01),
        "w_down": nrm(ks[27], (DEPTH, D_FF, D_MODEL), D_FF ** -0.5),
        "norm_final": 1.0 + nrm(ks[28], (D_MODEL,), 0.02),
    }


def reference(x_prompt, x_sample, cache_k_win, cache_v_win, state_ssm_re, state_ssm_im, state_conv,
              norm_mix, w_in, sinks, lam_re, lam_im, log_step, b_re, b_im, c_re, c_im, d_skip,
              w_glu, b_glu, g_attn, g_ssm, w_out, norm_ffn, w_up, conv_w, conv_b, w_down, norm_final):
    xp, xs = x_prompt, x_sample
    bp = x_prompt.shape[0]
    zero_h = jnp.zeros((bp, N_GROUPS, STATE), jnp.float32)
    zero_conv = jnp.zeros((bp, CONV_W - 1, 2 * D_FF), x_prompt.dtype)
    prompt_states, sample_states = [], []
    for l in range(DEPTH):
        p = {
            'norm_mix': norm_mix[l], 'w_in': w_in[l], 'sinks': sinks[l],
            'lam_re': lam_re[l], 'lam_im': lam_im[l], 'log_step': log_step[l],
            'b_re': b_re[l], 'b_im': b_im[l], 'c_re': c_re[l], 'c_im': c_im[l],
            'd_skip': d_skip[l], 'w_glu': w_glu[l], 'b_glu': b_glu[l],
            'g_attn': g_attn[l], 'g_ssm': g_ssm[l], 'w_out': w_out[l],
            'norm_ffn': norm_ffn[l], 'w_up': w_up[l], 'conv_w': conv_w[l],
            'conv_b': conv_b[l], 'w_down': w_down[l],
        }
        xp, sp = _layer(xp, p, _swa_prompt, zero_h, zero_h, zero_conv)
        attend_s = functools.partial(_swa_sample, k_buf=cache_k_win[l], v_buf=cache_v_win[l])
        xs, ss = _layer(xs, p, attend_s, state_ssm_re[l], state_ssm_im[l], state_conv[l])
        prompt_states.append(sp)
        sample_states.append(ss)
    y_prompt = _rmsnorm(xp, norm_final)
    y_sample = _rmsnorm(xs, norm_final)
    k_win_p, v_win_p, ssm_re_p, ssm_im_p, conv_p = (jnp.stack(z) for z in zip(*prompt_states))
    k_win_s, v_win_s, ssm_re_s, ssm_im_s, conv_s = (jnp.stack(z) for z in zip(*sample_states))
    return (y_prompt, y_sample, k_win_p, v_win_p, ssm_re_p, ssm_im_p, conv_p,
            k_win_s, v_win_s, ssm_re_s, ssm_im_s, conv_s)
```

```cpp
#include <hip/hip_runtime.h>
#include <hip/hip_cooperative_groups.h>
#include <cstdint>
#include <cstdio>
namespace cg = cooperative_groups;

#define DI __device__ __forceinline__
typedef unsigned short bf16_t;
typedef short bf16x8 __attribute__((ext_vector_type(8)));
typedef float f32x4 __attribute__((ext_vector_type(4)));
typedef unsigned u32x4 __attribute__((ext_vector_type(4)));
typedef unsigned u32x2 __attribute__((ext_vector_type(2)));

constexpr int MP = 32768, MT = 33280;
constexpr float EPS = 1e-5f;
constexpr float LOG2E = 1.4426950408889634f;

constexpr size_t O_Y = 0, O_KP = 34078720, O_VP = 34340864, O_RP = 34603008, O_IP = 34635776, O_CP = 34668544,
                 O_KS = 34840576, O_VS = 39034880, O_RS = 43229184, O_IS = 43753472, O_CS = 44277760;
constexpr size_t WS_WT = 0, WS_H = 43515904, WS_X = 111673344, WS_R = 247988224;
constexpr size_t WS_QKV = WS_R, WS_U = WS_R + 51118080, WS_ATT = WS_R + 119275520, WS_SSR = WS_R + 153354240, WS_SS2 = WS_R + 187432960;
constexpr size_t WS_ACT = WS_R;
constexpr size_t WS_HALO = 469499904, WS_UPS = 480509952, WS_ENDS = 491520000, WS_TOTAL = 492568576;
constexpr size_t WT_IN = 0, WT_GLU = 1310720, WT_OUT = 1572864, WT_UP = 2621440, WT_DOWN = 8126464, WT_LAYER = 10878976;
constexpr int LDS_BYTES = 136 * 1024;

struct Params {
  const float* in[29];
  float* out;
  char* ws;
};

typedef const __attribute__((address_space(4))) Params CParams;
DI CParams* launder(CParams* p) { asm volatile("" : "+s"(p)); return p; }
DI unsigned pk2(float lo, float hi) { unsigned r; asm("v_cvt_pk_bf16_f32 %0, %1, %2" : "=v"(r) : "v"(lo), "v"(hi)); return r; }
DI float bflo(unsigned u) { return __uint_as_float(u << 16); }
DI float bfhi(unsigned u) { return __uint_as_float(u & 0xffff0000u); }
DI float bf2f(bf16_t b) { return __uint_as_float(((unsigned)b) << 16); }
DI float shx(float v, int o, int lane) { return __int_as_float(__builtin_amdgcn_ds_bpermute((lane ^ o) << 2, __float_as_int(v))); }
DI float wave_sum(float v, int lane) {
#pragma unroll
  for (int o = 1; o < 64; o <<= 1) v += shx(v, o, lane);
  return v;
}
DI int tid_opq() { int t = threadIdx.x; asm volatile("" : "+v"(t)); return t; }
DI bf16x8 as_bf16x8(u32x4 v) { return __builtin_bit_cast(bf16x8, v); }
#define MFMA16(a, b, c) __builtin_amdgcn_mfma_f32_16x16x32_bf16((a), (b), (c), 0, 0, 0)

DI void transpose_item(const float* __restrict__ W, int K, int N, bf16_t* __restrict__ WT, int item, float* scr, int tid, bool perm_up) {
  const int nblk = N / 64, kb = item / nblk, nb = item % nblk, k0 = kb * 64, n0 = nb * 64;
  int src_n0 = n0;
  if (perm_up) { const int tile = n0 >> 8, j = n0 & 255; src_n0 = (j < 128) ? tile * 128 + j : 2688 + tile * 128 + (j - 128); }
#pragma unroll
  for (int i = 0; i < 8; ++i) { const int kk = (tid >> 6) + 8 * i, nn = tid & 63; scr[kk * 65 + nn] = W[(size_t)(k0 + kk) * N + src_n0 + nn]; }
  __syncthreads();
  {
    const int nn = tid >> 3, c = tid & 7;
    const float* s = scr + (8 * c) * 65 + nn;
    u32x4 o;
    o.x = pk2(s[0 * 65], s[1 * 65]); o.y = pk2(s[2 * 65], s[3 * 65]); o.z = pk2(s[4 * 65], s[5 * 65]); o.w = pk2(s[6 * 65], s[7 * 65]);
    *(u32x4*)(WT + (size_t)(n0 + nn) * K + k0 + 8 * c) = o;
  }
  __syncthreads();
}

DI void norm_row_bf16(const float* __restrict__ xr, const float* __restrict__ g, bf16_t* __restrict__ orow, int lane) {
  f32x4 v[4]; float s = 0.f;
#pragma unroll
  for (int j = 0; j < 4; ++j) { v[j] = ((const f32x4*)xr)[lane + 64 * j]; s += v[j].x * v[j].x + v[j].y * v[j].y + v[j].z * v[j].z + v[j].w * v[j].w; }
  s = wave_sum(s, lane);
  const float rstd = rsqrtf(s * (1.f / 1024.f) + EPS);
#pragma unroll
  for (int j = 0; j < 4; ++j) {
    const f32x4 gg = ((const f32x4*)g)[lane + 64 * j];
    u32x2 o; o.x = pk2(v[j].x * rstd * gg.x, v[j].y * rstd * gg.y); o.y = pk2(v[j].z * rstd * gg.z, v[j].w * rstd * gg.w);
    ((u32x2*)orow)[lane + 64 * j] = o;
  }
}
DI void norm_row_f32(const float* __restrict__ xr, const float* __restrict__ g, float* __restrict__ orow, int lane) {
  f32x4 v[4]; float s = 0.f;
#pragma unroll
  for (int j = 0; j < 4; ++j) { v[j] = ((const f32x4*)xr)[lane + 64 * j]; s += v[j].x * v[j].x + v[j].y * v[j].y + v[j].z * v[j].z + v[j].w * v[j].w; }
  s = wave_sum(s, lane);
  const float rstd = rsqrtf(s * (1.f / 1024.f) + EPS);
#pragma unroll
  for (int j = 0; j < 4; ++j) {
    const f32x4 gg = ((const f32x4*)g)[lane + 64 * j];
    f32x4 o; o.x = v[j].x * rstd * gg.x; o.y = v[j].y * rstd * gg.y; o.z = v[j].z * rstd * gg.z; o.w = v[j].w * rstd * gg.w;
    ((f32x4*)orow)[lane + 64 * j] = o;
  }
}
DI const float* xrow_in(CParams& P, int r) { return r < MP ? P.in[0] + (size_t)r * 1024 : P.in[1] + (size_t)(r - MP) * 1024; }

DI void norm_phase(CParams& P, int mode, const float* g) {
  const int tid = tid_opq(); const int wid = tid >> 6, lane = tid & 63;
  const float* xcur = (const float*)(P.ws + WS_X);
  bf16_t* h = (bf16_t*)(P.ws + WS_H);
  for (int r = blockIdx.x * 8 + wid; r < MT; r += gridDim.x * 8) {
    const float* xr = mode == 0 ? xrow_in(P, r) : xcur + (size_t)r * 1024;
    norm_row_bf16(xr, g, h + (size_t)r * 1024, lane);
  }
}
DI void final_norm_phase(CParams& P) {
  const int tid = tid_opq(); const int wid = tid >> 6, lane = tid & 63;
  const float* xcur = (const float*)(P.ws + WS_X);
  for (int r = blockIdx.x * 8 + wid; r < MT; r += gridDim.x * 8)
    norm_row_f32(xcur + (size_t)r * 1024, P.in[28], P.out + O_Y + (size_t)r * 1024, lane);
}

DI void phase0(CParams& P, char* shm) {
  const int tid = tid_opq();
  constexpr int per_layer = 320 + 64 + 256 + 1344 + 672;
  bf16_t* wt0 = (bf16_t*)(P.ws + WS_WT);
  for (int it = blockIdx.x; it < 2 * per_layer; it += gridDim.x) {
    const int l = it / per_layer; int r = it % per_layer;
    bf16_t* wt = wt0 + (size_t)l * WT_LAYER;
    if (r < 320) { transpose_item(P.in[8] + (size_t)l * 1024 * 1280, 1024, 1280, wt + WT_IN, r, (float*)shm, tid, false); continue; }
    r -= 320;
    if (r < 64) { transpose_item(P.in[18] + (size_t)l * 512 * 512, 512, 512, wt + WT_GLU, r, (float*)shm, tid, false); continue; }
    r -= 64;
    if (r < 256) { transpose_item(P.in[22] + (size_t)l * 1024 * 1024, 1024, 1024, wt + WT_OUT, r, (float*)shm, tid, false); continue; }
    r -= 256;
    if (r < 1344) { transpose_item(P.in[24] + (size_t)l * 1024 * 5376, 1024, 5376, wt + WT_UP, r, (float*)shm, tid, true); continue; }
    r -= 1344;
    transpose_item(P.in[27] + (size_t)l * 2688 * 1024, 2688, 1024, wt + WT_DOWN, r, (float*)shm, tid, false);
  }
  norm_phase(P, 0, P.in[7]);
}

DI int lds_byte(int r, int c) { const int st = (r >> 4) * 2 + (c >> 5), rr = r & 15, cc = c & 31, ob = rr * 64 + cc * 2; return st * 1024 + (ob ^ (((ob >> 9) & 1) << 5)); }
DI void stage_rc(int b, int& R, int& C) { const int st = b / 1024, sb = b % 1024, swz = sb ^ (((sb >> 9) & 1) << 5); R = (st >> 1) * 16 + swz / 64; C = (st & 1) * 32 + (swz % 64) / 2; }
DI void gl_lds16(const void* g, void* l) {
  __builtin_amdgcn_global_load_lds((const __attribute__((address_space(1))) void*)g, (__attribute__((address_space(3))) void*)l, 16, 0, 0);
}

template <class Epi>
DI void gemm_phase(const bf16_t* __restrict__ A, const bf16_t* __restrict__ Bt, int nM, int nN, int K, const Epi& epi, char* shm) {
  const int tid = tid_opq(); const int wid = tid >> 6, lane = tid & 63, wr = wid >> 2, wc = wid & 3, fr = lane & 15, fq = lane >> 4;
  const int nt = K / 64, ntiles = nM * nN;
  int sr0, sc0, sr1, sc1; stage_rc(tid * 16, sr0, sc0); stage_rc(tid * 16 + 8192, sr1, sc1);
  const unsigned go0 = (unsigned)(sr0 * K + sc0) * 2u, go1 = (unsigned)(sr1 * K + sc1) * 2u;
  const unsigned goh = (unsigned)(128 * K) * 2u;
  const int lob = fr * 64 + fq * 16;
  const int lswz = lob ^ (((lob >> 9) & 1) << 5);
  char* const a_base = shm + lswz + wr * 8192;
  char* const b_base = shm + 65536 + lswz + wc * 4096;
  char* const st_base = shm + tid * 16;
  for (int tile = blockIdx.x; tile < ntiles; tile += gridDim.x) {
    const int pm = tile / nN, pn = tile % nN;
    const char* Ab = (const char*)(A + (size_t)pm * 256 * K);
    const char* Bb = (const char*)(Bt + (size_t)pn * 256 * K);
    f32x4 acc[2][2][4][2];
#pragma unroll
    for (int a = 0; a < 2; ++a)
#pragma unroll
      for (int b = 0; b < 2; ++b)
#pragma unroll
        for (int m = 0; m < 4; ++m)
#pragma unroll
          for (int n = 0; n < 2; ++n) acc[a][b][m][n] = (f32x4){0.f, 0.f, 0.f, 0.f};

#define GEMM_STAGE(buf, kt)                                                         \
  do {                                                                              \
    const char* ak_ = Ab + (size_t)(kt) * 128;                                      \
    const char* bk_ = Bb + (size_t)(kt) * 128;                                      \
    char* la_ = st_base + (buf) * 32768;                                            \
    gl_lds16(ak_ + go0, la_);                                                       \
    gl_lds16(ak_ + go1, la_ + 8192);                                                \
    gl_lds16(ak_ + goh + go0, la_ + 16384);                                         \
    gl_lds16(ak_ + goh + go1, la_ + 16384 + 8192);                                  \
    gl_lds16(bk_ + go0, la_ + 65536);                                               \
    gl_lds16(bk_ + go1, la_ + 65536 + 8192);                                        \
    gl_lds16(bk_ + goh + go0, la_ + 65536 + 16384);                                 \
    gl_lds16(bk_ + goh + go1, la_ + 65536 + 16384 + 8192);                          \
  } while (0)

    GEMM_STAGE(0, 0);
    asm volatile("s_waitcnt vmcnt(0)" ::: "memory");
    __syncthreads();
    for (int t = 0; t < nt; ++t) {
      const int cur = t & 1;
      if (t + 1 < nt) GEMM_STAGE(cur ^ 1, t + 1);
      const char* ac = a_base + cur * 32768;
      const char* bc = b_base + cur * 32768;
      bf16x8 Bf[2][2][2];
#pragma unroll
      for (int bj = 0; bj < 2; ++bj)
#pragma unroll
        for (int n = 0; n < 2; ++n)
#pragma unroll
          for (int k = 0; k < 2; ++k) Bf[bj][n][k] = *(const bf16x8*)(bc + bj * 16384 + n * 2048 + k * 1024);
#pragma unroll
      for (int ai = 0; ai < 2; ++ai) {
        bf16x8 At[4][2];
        if (ai == 1) __builtin_amdgcn_sched_barrier(0);
#pragma unroll
        for (int m = 0; m < 4; ++m)
#pragma unroll
          for (int k = 0; k < 2; ++k) At[m][k] = *(const bf16x8*)(ac + ai * 16384 + m * 2048 + k * 1024);
#pragma unroll
        for (int bj = 0; bj < 2; ++bj)
#pragma unroll
          for (int m = 0; m < 4; ++m)
#pragma unroll
            for (int n = 0; n < 2; ++n)
#pragma unroll
              for (int k = 0; k < 2; ++k) acc[ai][bj][m][n] = MFMA16(Bf[bj][n][k], At[m][k], acc[ai][bj][m][n]);
      }
      asm volatile("s_waitcnt vmcnt(0)" ::: "memory");
      __syncthreads();
    }
    {
      int wr_ = wr, wc_ = wc, fr_ = fr, fq_ = fq;
      asm volatile("" : "+v"(wr_), "+v"(wc_), "+v"(fr_), "+v"(fq_));
      epi(acc, pm, pn, wr_, wc_, fr_, fq_, shm);
    }
  }
}

struct EpiIn {
  int l; bf16_t* qkv; float* u; float* out;
  DI void operator()(const f32x4 (&acc)[2][2][4][2], int pm, int pn, int wr, int wc, int fr, int fq, char*) const {
#pragma unroll
    for (int ai = 0; ai < 2; ++ai)
#pragma unroll
      for (int m = 0; m < 4; ++m) {
        const int row = pm * 256 + ai * 128 + wr * 64 + m * 16 + fr;
#pragma unroll
        for (int bj = 0; bj < 2; ++bj)
#pragma unroll
          for (int n = 0; n < 2; ++n) {
            const int col = pn * 256 + bj * 128 + wc * 32 + n * 16 + fq * 4;
            const f32x4 v = acc[ai][bj][m][n];
            if (col < 768) {
              u32x2 o; o.x = pk2(v.x, v.y); o.y = pk2(v.z, v.w);
              *(u32x2*)(qkv + (size_t)row * 768 + col) = o;
              if (col >= 512) {
                const bool isk = col < 640; const int cc = col - (isk ? 512 : 640);
                if (row < MP) {
                  const int t = row & 4095, b = row >> 12;
                  if (t >= 3968) *(f32x4*)(out + (isk ? O_KP : O_VP) + ((size_t)((l * 8 + b) * 128 + (t - 3968))) * 128 + cc) = v;
                } else {
                  const int rs = row - MP, b = rs >> 2, t = rs & 3;
                  *(f32x4*)(out + (isk ? O_KS : O_VS) + ((size_t)((l * 128 + b) * 128 + 124 + t)) * 128 + cc) = v;
                }
              }
            } else {
              *(f32x4*)(u + (size_t)row * 512 + (col - 768)) = v;
            }
          }
      }
  }
};
struct EpiGlu {
  const bf16_t* ssr; bf16_t* ss2; const float* bias;
  DI void operator()(const f32x4 (&acc)[2][2][4][2], int pm, int pn, int wr, int wc, int fr, int fq, char*) const {
#pragma unroll
    for (int ai = 0; ai < 2; ++ai)
#pragma unroll
      for (int m = 0; m < 4; ++m) {
        const int row = pm * 256 + ai * 128 + wr * 64 + m * 16 + fr;
#pragma unroll
        for (int bj = 0; bj < 2; ++bj)
#pragma unroll
          for (int n = 0; n < 2; ++n) {
            const int col = pn * 256 + bj * 128 + wc * 32 + n * 16 + fq * 4;
            const f32x4 v = acc[ai][bj][m][n];
            asm volatile("" ::: "memory");
            const f32x4 bb = *(const f32x4*)(bias + col);
            const u32x2 sv = *(const u32x2*)(ssr + (size_t)row * 512 + col);
            const float s0 = bflo(sv.x), s1 = bfhi(sv.x), s2 = bflo(sv.y), s3 = bfhi(sv.y);
            const float o0 = s0 / (1.f + __expf(-(v.x + bb.x))), o1 = s1 / (1.f + __expf(-(v.y + bb.y)));
            const float o2 = s2 / (1.f + __expf(-(v.z + bb.z))), o3 = s3 / (1.f + __expf(-(v.w + bb.w)));
            u32x2 o; o.x = pk2(o0, o1); o.y = pk2(o2, o3);
            *(u32x2*)(ss2 + (size_t)row * 512 + col) = o;
          }
      }
  }
};
struct EpiRes {
  const float* xp; const float* xs; float* xcur; int from_in;
  DI void operator()(const f32x4 (&acc)[2][2][4][2], int pm, int pn, int wr, int wc, int fr, int fq, char*) const {
#pragma unroll
    for (int ai = 0; ai < 2; ++ai)
#pragma unroll
      for (int m = 0; m < 4; ++m) {
        const int row = pm * 256 + ai * 128 + wr * 64 + m * 16 + fr;
        const float* src = from_in ? (row < MP ? xp + (size_t)row * 1024 : xs + (size_t)(row - MP) * 1024) : xcur + (size_t)row * 1024;
        asm volatile("" ::: "memory");
#pragma unroll
        for (int bj = 0; bj < 2; ++bj)
#pragma unroll
          for (int n = 0; n < 2; ++n) {
            const int col = pn * 256 + bj * 128 + wc * 32 + n * 16 + fq * 4;
            const f32x4 x = *(const f32x4*)(src + col);
            *(f32x4*)(xcur + (size_t)row * 1024 + col) = x + acc[ai][bj][m][n];
          }
      }
  }
};
struct EpiUp {
  int l; bf16_t* act; float* halo; float* ups; const float* conv_w; const float* conv_b; float* out;
  DI void operator()(const f32x4 (&acc)[2][2][4][2], int pm, int pn, int wr, int wc, int fr, int fq, char* shm) const {
    const int chb = pn * 128;
    if (pm >= 128) {
#pragma unroll
      for (int ai = 0; ai < 2; ++ai)
#pragma unroll
        for (int m = 0; m < 4; ++m) {
          const int rs = (pm - 128) * 256 + ai * 128 + wr * 64 + m * 16 + fr;
#pragma unroll
          for (int bj = 0; bj < 2; ++bj)
#pragma unroll
            for (int n = 0; n < 2; ++n) {
              const int c = wc * 32 + n * 16 + fq * 4;
              *(f32x4*)(ups + (size_t)rs * 5376 + (bj ? 2688 : 0) + chb + c) = acc[ai][bj][m][n];
            }
        }
      return;
    }
    bf16_t* S = (bf16_t*)shm;
#pragma unroll
    for (int ai = 0; ai < 2; ++ai)
#pragma unroll
      for (int m = 0; m < 4; ++m) {
        const int R = ai * 128 + wr * 64 + m * 16 + fr;
#pragma unroll
        for (int bj = 0; bj < 2; ++bj)
#pragma unroll
          for (int n = 0; n < 2; ++n) {
            const int c = wc * 32 + n * 16 + fq * 4;
            const f32x4 v = acc[ai][bj][m][n];
            u32x2 o; o.x = pk2(v.x, v.y); o.y = pk2(v.z, v.w);
            *(u32x2*)(S + R * 264 + bj * 128 + c) = o;
            if (((ai == 0 && m == 0) || (ai == 1 && m == 3)) && (R < 2 || R >= 254)) {
              const int hr = R < 2 ? R : R - 252;
              const int oc = (bj ? 2688 : 0) + chb + c;
              *(f32x4*)(halo + ((size_t)(pm * 4 + hr)) * 5376 + oc) = v;
              if (R >= 254 && (pm & 15) == 15) *(f32x4*)(out + O_CP + ((size_t)((l * 8 + (pm >> 4)) * 2 + (R - 254))) * 5376 + oc) = v;
            }
          }
      }
    __syncthreads();
    {
      const int tid = tid_opq(); const int cg8 = (tid & 15) * 8, rbase = tid >> 4;
      const float* cw = conv_w + (size_t)l * 3 * 5376;
      const float* cb = conv_b + (size_t)l * 5376;
      float wa[3][8], wg[3][8], ba[8], bg[8];
#pragma unroll
      for (int i = 0; i < 3; ++i) {
        const f32x4 a0 = *(const f32x4*)(cw + i * 5376 + chb + cg8), a1 = *(const f32x4*)(cw + i * 5376 + chb + cg8 + 4);
        const f32x4 g0 = *(const f32x4*)(cw + i * 5376 + 2688 + chb + cg8), g1 = *(const f32x4*)(cw + i * 5376 + 2688 + chb + cg8 + 4);
        wa[i][0] = a0.x; wa[i][1] = a0.y; wa[i][2] = a0.z; wa[i][3] = a0.w; wa[i][4] = a1.x; wa[i][5] = a1.y; wa[i][6] = a1.z; wa[i][7] = a1.w;
        wg[i][0] = g0.x; wg[i][1] = g0.y; wg[i][2] = g0.z; wg[i][3] = g0.w; wg[i][4] = g1.x; wg[i][5] = g1.y; wg[i][6] = g1.z; wg[i][7] = g1.w;
      }
      {
        const f32x4 a0 = *(const f32x4*)(cb + chb + cg8), a1 = *(const f32x4*)(cb + chb + cg8 + 4);
        const f32x4 g0 = *(const f32x4*)(cb + 2688 + chb + cg8), g1 = *(const f32x4*)(cb + 2688 + chb + cg8 + 4);
        ba[0] = a0.x; ba[1] = a0.y; ba[2] = a0.z; ba[3] = a0.w; ba[4] = a1.x; ba[5] = a1.y; ba[6] = a1.z; ba[7] = a1.w;
        bg[0] = g0.x; bg[1] = g0.y; bg[2] = g0.z; bg[3] = g0.w; bg[4] = g1.x; bg[5] = g1.y; bg[6] = g1.z; bg[7] = g1.w;
      }
#pragma unroll 1
      for (int i = 0; i < 8; ++i) {
        const int R = rbase + 32 * i;
        if (R < 2) continue;
        u32x4 av[3], gv[3];
#pragma unroll
        for (int d = 0; d < 3; ++d) { av[d] = *(const u32x4*)(S + (R - 2 + d) * 264 + cg8); gv[d] = *(const u32x4*)(S + (R - 2 + d) * 264 + 128 + cg8); }
        float res[8];
#pragma unroll
        for (int e = 0; e < 8; ++e) {
          float ca = ba[e], cgv = bg[e];
#pragma unroll
          for (int d = 0; d < 3; ++d) {
            const unsigned aw = av[d][e >> 1], gw = gv[d][e >> 1];
            const float af = (e & 1) ? bfhi(aw) : bflo(aw), gf = (e & 1) ? bfhi(gw) : bflo(gw);
            ca += wa[d][e] * af; cgv += wg[d][e] * gf;
          }
          res[e] = ca * cgv / (1.f + __expf(-cgv));
        }
        u32x4 o; o.x = pk2(res[0], res[1]); o.y = pk2(res[2], res[3]); o.z = pk2(res[4], res[5]); o.w = pk2(res[6], res[7]);
        *(u32x4*)(act + (size_t)(pm * 256 + R) * 2688 + chb + cg8) = o;
      }
    }
    __syncthreads();
  }
};

DI float conv_act(float a0, float a1, float a2, float g0, float g1, float g2, const float* cw, const float* cb, int ch) {
  const float ca = cb[ch] + cw[ch] * a0 + cw[5376 + ch] * a1 + cw[2 * 5376 + ch] * a2;
  const float cgv = cb[2688 + ch] + cw[2688 + ch] * g0 + cw[5376 + 2688 + ch] * g1 + cw[2 * 5376 + 2688 + ch] * g2;
  return ca * cgv / (1.f + __expf(-cgv));
}
DI void fixup_phase(CParams& P, int l) {
  const float* halo = (const float*)(P.ws + WS_HALO);
  const float* ups = (const float*)(P.ws + WS_UPS);
  bf16_t* act = (bf16_t*)(P.ws + WS_ACT);
  const float* cw = P.in[25] + (size_t)l * 3 * 5376;
  const float* cb = P.in[26] + (size_t)l * 5376;
  const float* sconv = P.in[6] + (size_t)l * 128 * 2 * 5376;
  const int gt = blockIdx.x * 512 + tid_opq(), nthr = gridDim.x * 512;
  for (int idx = gt; idx < 128 * 2 * 2688; idx += nthr) {
    const int ch = idx % 2688, i = (idx / 2688) & 1, pm = idx / (2 * 2688);
    const bool first = (pm & 15) == 0;
    const float* cur = halo + (size_t)(pm * 4 + i) * 5376;
    const float* p1 = i == 1 ? halo + (size_t)(pm * 4 + 0) * 5376 : halo + (size_t)((pm - 1) * 4 + 3) * 5376;
    const float* p2 = i == 1 ? halo + (size_t)((pm - 1) * 4 + 3) * 5376 : halo + (size_t)((pm - 1) * 4 + 2) * 5376;
    const bool v1 = (i == 1) || !first, v2 = !first;
    const float a2 = cur[ch], g2 = cur[2688 + ch];
    const float a1 = v1 ? p1[ch] : 0.f, g1 = v1 ? p1[2688 + ch] : 0.f;
    const float a0 = v2 ? p2[ch] : 0.f, g0 = v2 ? p2[2688 + ch] : 0.f;
    const float r = conv_act(a0, a1, a2, g0, g1, g2, cw, cb, ch);
    act[(size_t)(pm * 256 + i) * 2688 + ch] = (bf16_t)(pk2(r, 0.f) & 0xffffu);
  }
  for (int idx = gt; idx < 512 * 2688; idx += nthr) {
    const int ch = idx % 2688, rs = idx / 2688, b = rs >> 2, t = rs & 3;
    const float* cur = ups + (size_t)rs * 5376;
    const float* sc = sconv + (size_t)b * 2 * 5376;
    const float* p1 = t >= 1 ? cur - 5376 : sc + 5376;
    const float* p2 = t >= 2 ? cur - 2 * 5376 : sc + (size_t)t * 5376;
    const float a2 = cur[ch], g2 = cur[2688 + ch];
    const float r = conv_act(p2[ch], p1[ch], a2, p2[2688 + ch], p1[2688 + ch], g2, cw, cb, ch);
    act[(size_t)(MP + rs) * 2688 + ch] = (bf16_t)(pk2(r, 0.f) & 0xffffu);
    if (t >= 2) {
      float* o = P.out + O_CS + ((size_t)((l * 128 + b) * 2 + (t - 2))) * 5376;
      o[ch] = a2; o[2688 + ch] = g2;
    }
  }
}

DI void attn_prompt_unit(CParams& P, int l, int unit, char* shm) {
  const int tid = tid_opq(); const int wid = tid >> 6, lane = tid & 63, fr = lane & 15, fq = lane >> 4;
  const int kvh = unit & 1, qb = (unit >> 1) & 31, b = unit >> 6;
  const bf16_t* qkv = (const bf16_t*)(P.ws + WS_QKV);
  bf16_t* attn = (bf16_t*)(P.ws + WS_ATT);
  bf16_t* Ks = (bf16_t*)shm;
  bf16_t* Vt = (bf16_t*)(shm + 36864);
#pragma unroll
  for (int p = 0; p < 4; ++p) {
    const int key = p * 64 + (tid >> 3), seg = tid & 7, kpos = qb * 128 - 128 + key;
    u32x4 v = (u32x4){0u, 0u, 0u, 0u};
    if (kpos >= 0) v = *(const u32x4*)(qkv + (size_t)(b * 4096 + kpos) * 768 + 512 + kvh * 64 + seg * 8);
    *(u32x4*)(Ks + key * 72 + seg * 8) = v;
  }
#pragma unroll
  for (int p = 0; p < 4; ++p) {
    const int key = p * 64 + (tid & 63), seg = tid >> 6, kpos = qb * 128 - 128 + key;
    u32x4 v = (u32x4){0u, 0u, 0u, 0u};
    if (kpos >= 0) v = *(const u32x4*)(qkv + (size_t)(b * 4096 + kpos) * 768 + 640 + kvh * 64 + seg * 8);
#pragma unroll
    for (int e = 0; e < 4; ++e) {
      Vt[(seg * 8 + 2 * e) * 264 + key] = (bf16_t)(v[e] & 0xffffu);
      Vt[(seg * 8 + 2 * e + 1) * 264 + key] = (bf16_t)(v[e] >> 16);
    }
  }
  __syncthreads();
  const int hh = wid >> 1, half = wid & 1, head = kvh * 4 + hh, q0l = half * 64;
  const float slope2 = exp2f(-(float)(head + 1)) * LOG2E;
  const float sink2 = P.in[9][l * 8 + head] * LOG2E;
  const float scale2 = 0.125f * LOG2E;
  bf16x8 qf[4][2];
#pragma unroll
  for (int qt = 0; qt < 4; ++qt)
#pragma unroll
    for (int kk = 0; kk < 2; ++kk)
      qf[qt][kk] = *(const bf16x8*)(qkv + (size_t)(b * 4096 + qb * 128 + q0l + qt * 16 + fr) * 768 + head * 64 + kk * 32 + fq * 8);
  float mrow[4], lsum[4];
  f32x4 o[4][4];
#pragma unroll
  for (int qt = 0; qt < 4; ++qt) {
    mrow[qt] = sink2; lsum[qt] = fq == 0 ? 1.f : 0.f;
#pragma unroll
    for (int dt = 0; dt < 4; ++dt) o[dt][qt] = (f32x4){0.f, 0.f, 0.f, 0.f};
  }
  for (int kt = 0; kt < 3; ++kt) {
    const int klb = q0l + kt * 64;
    f32x4 s[4][4];
#pragma unroll
    for (int ks = 0; ks < 4; ++ks) {
      const bf16x8 kf0 = *(const bf16x8*)(Ks + (klb + ks * 16 + fr) * 72 + fq * 8);
      const bf16x8 kf1 = *(const bf16x8*)(Ks + (klb + ks * 16 + fr) * 72 + 32 + fq * 8);
#pragma unroll
      for (int qt = 0; qt < 4; ++qt) {
        f32x4 z = (f32x4){0.f, 0.f, 0.f, 0.f};
        z = MFMA16(kf0, qf[qt][0], z);
        s[ks][qt] = MFMA16(kf1, qf[qt][1], z);
      }
    }
    bf16x8 pf[4][2];
#pragma unroll
    for (int qt = 0; qt < 4; ++qt) {
      const int qloc = q0l + qt * 16 + fr;
      float mx = -3.0e38f;
#pragma unroll
      for (int ks = 0; ks < 4; ++ks)
#pragma unroll
        for (int j = 0; j < 4; ++j) {
          const int kl = klb + ks * 16 + fq * 4 + j;
          const int dist = qloc + 128 - kl;
          const bool valid = dist >= 0 && dist < 128 && (qb > 0 || kl >= 128);
          const float val = valid ? s[ks][qt][j] * scale2 - slope2 * (float)dist : -1.0e30f;
          s[ks][qt][j] = val;
          mx = fmaxf(mx, val);
        }
      mx = fmaxf(mx, shx(mx, 16, lane));
      mx = fmaxf(mx, shx(mx, 32, lane));
      const float mnew = fmaxf(mrow[qt], mx);
      const float alpha = exp2f(mrow[qt] - mnew);
      mrow[qt] = mnew;
      float psum = 0.f;
#pragma unroll
      for (int ks = 0; ks < 4; ++ks)
#pragma unroll
        for (int j = 0; j < 4; ++j) { const float pv = exp2f(s[ks][qt][j] - mnew); s[ks][qt][j] = pv; psum += pv; }
      lsum[qt] = lsum[qt] * alpha + psum;
#pragma unroll
      for (int dt = 0; dt < 4; ++dt) o[dt][qt] = o[dt][qt] * alpha;
#pragma unroll
      for (int ksp = 0; ksp < 2; ++ksp) {
        u32x4 pw;
        pw.x = pk2(s[2 * ksp][qt][0], s[2 * ksp][qt][1]); pw.y = pk2(s[2 * ksp][qt][2], s[2 * ksp][qt][3]);
        pw.z = pk2(s[2 * ksp + 1][qt][0], s[2 * ksp + 1][qt][1]); pw.w = pk2(s[2 * ksp + 1][qt][2], s[2 * ksp + 1][qt][3]);
        pf[qt][ksp] = as_bf16x8(pw);
      }
    }
#pragma unroll
    for (int ksp = 0; ksp < 2; ++ksp)
#pragma unroll
      for (int dt = 0; dt < 4; ++dt) {
        const u32x2 v0 = *(const u32x2*)(Vt + (dt * 16 + fr) * 264 + klb + (2 * ksp) * 16 + fq * 4);
        const u32x2 v1 = *(const u32x2*)(Vt + (dt * 16 + fr) * 264 + klb + (2 * ksp + 1) * 16 + fq * 4);
        const bf16x8 vf = as_bf16x8((u32x4){v0.x, v0.y, v1.x, v1.y});
#pragma unroll
        for (int qt = 0; qt < 4; ++qt) o[dt][qt] = MFMA16(vf, pf[qt][ksp], o[dt][qt]);
      }
  }
#pragma unroll
  for (int qt = 0; qt < 4; ++qt) {
    float lt = lsum[qt];
    lt += shx(lt, 16, lane); lt += shx(lt, 32, lane);
    const float inv = 1.f / lt;
    const size_t row = (size_t)(b * 4096 + qb * 128 + q0l + qt * 16 + fr);
#pragma unroll
    for (int dt = 0; dt < 4; ++dt) {
      const f32x4 v = o[dt][qt] * inv;
      u32x2 ov; ov.x = pk2(v.x, v.y); ov.y = pk2(v.z, v.w);
      *(u32x2*)(attn + row * 512 + head * 64 + dt * 16 + fq * 4) = ov;
    }
  }
  __syncthreads();
}

DI void attn_sample_unit(CParams& P, int l, int unit, char* shm) {
  const int tid = tid_opq();
  const int kvh = unit & 1, b = unit >> 1;
  const bf16_t* qkv = (const bf16_t*)(P.ws + WS_QKV);
  bf16_t* attn = (bf16_t*)(P.ws + WS_ATT);
  float* Ksf = (float*)shm;
  float* Vsf = Ksf + 132 * 65;
  float* Qsf = Vsf + 132 * 65;
  float* Ps = Qsf + 16 * 64;
  const float* ck = P.in[2] + (size_t)(l * 128 + b) * 128 * 128;
  const float* cv = P.in[3] + (size_t)(l * 128 + b) * 128 * 128;
  float* okw = P.out + O_KS + (size_t)(l * 128 + b) * 128 * 128;
  float* ovw = P.out + O_VS + (size_t)(l * 128 + b) * 128 * 128;
#pragma unroll 4
  for (int i = 0; i < 16; ++i) {
    const int idx = tid + 512 * i, key = idx >> 6, d = idx & 63;
    const float kv = ck[key * 128 + kvh * 64 + d], vv = cv[key * 128 + kvh * 64 + d];
    Ksf[key * 65 + d] = kv; Vsf[key * 65 + d] = vv;
    if (key >= 4) { okw[(key - 4) * 128 + kvh * 64 + d] = kv; ovw[(key - 4) * 128 + kvh * 64 + d] = vv; }
  }
  if (tid < 256) {
    const int t = tid >> 6, d = tid & 63; const size_t row = (size_t)(MP + b * 4 + t);
    Ksf[(128 + t) * 65 + d] = bf2f(qkv[row * 768 + 512 + kvh * 64 + d]);
    Vsf[(128 + t) * 65 + d] = bf2f(qkv[row * 768 + 640 + kvh * 64 + d]);
  }
#pragma unroll
  for (int i = 0; i < 2; ++i) {
    const int idx = tid + 512 * i, rq = idx >> 6, d = idx & 63, hh = rq >> 2, t = rq & 3;
    Qsf[rq * 64 + d] = bf2f(qkv[(size_t)(MP + b * 4 + t) * 768 + (kvh * 4 + hh) * 64 + d]);
  }
  __syncthreads();
  const int rq = tid >> 5, kl = tid & 31, hh = rq >> 2, t = rq & 3, head = kvh * 4 + hh;
  {
    const float slope = exp2f(-(float)(head + 1));
    const float sink = P.in[9][l * 8 + head];
    float sc[5]; float mx = sink;
#pragma unroll
    for (int i = 0; i < 5; ++i) {
      const int key = kl + 32 * i;
      float val = -1.0e30f;
      if (key < 132) {
        float dot = 0.f;
#pragma unroll 8
        for (int d = 0; d < 64; ++d) dot += Qsf[rq * 64 + d] * Ksf[key * 65 + d];
        const int dist = key < 128 ? (t + 128 - key) : (t - (key - 128));
        if (dist >= 0 && dist < 128) val = dot * 0.125f - slope * (float)dist;
      }
      sc[i] = val; mx = fmaxf(mx, val);
    }
#pragma unroll
    for (int o = 1; o < 32; o <<= 1) mx = fmaxf(mx, shx(mx, o, tid & 63));
    float sum = 0.f;
#pragma unroll
    for (int i = 0; i < 5; ++i) { sc[i] = __expf(sc[i] - mx); sum += sc[i]; }
#pragma unroll
    for (int o = 1; o < 32; o <<= 1) sum += shx(sum, o, tid & 63);
    sum += __expf(sink - mx);
    const float inv = 1.f / sum;
#pragma unroll
    for (int i = 0; i < 5; ++i) { const int key = kl + 32 * i; if (key < 132) Ps[rq * 136 + key] = sc[i] * inv; }
  }
  __syncthreads();
  {
    float a0 = 0.f, a1 = 0.f;
#pragma unroll 4
    for (int key = 0; key < 132; ++key) { const float p = Ps[rq * 136 + key]; a0 += p * Vsf[key * 65 + kl]; a1 += p * Vsf[key * 65 + kl + 32]; }
    const size_t row = (size_t)(MP + b * 4 + t);
    attn[row * 512 + head * 64 + kl] = (bf16_t)(pk2(a0, 0.f) & 0xffffu);
    attn[row * 512 + head * 64 + kl + 32] = (bf16_t)(pk2(a1, 0.f) & 0xffffu);
  }
  __syncthreads();
}

DI void sincos_rev(double ang, float& s, float& c) {
  double r = ang * 0.15915494309189535;
  r -= __builtin_rint(r);
  const float x = (float)(r * 6.283185307179586);
  s = sinf(x); c = cosf(x);
}
DI void s5_item(CParams& P, int l, int mode, int item, char* wl, int lane) {
  int b, c, g;
  g = item & 31;
  if (mode == 2) { b = item >> 5; c = 0; } else { c = (item >> 5) & 7; b = item >> 8; }
  const int n = lane, fr = lane & 15, fq = lane >> 4;
  const int gi = (l * 32 + g) * 64 + n;
  const float lr = P.in[10][gi], li = P.in[11][gi];
  const float dt = expf(P.in[12][l * 32 + g]);
  float lbr, lbi;
  {
    const float mag = expf(lr * dt); float sn, cs; sincos_rev((double)li * (double)dt, sn, cs);
    lbr = mag * cs; lbi = mag * sn;
  }
  float bbr[16], bbi[16];
  {
    const float den = 1.f / (lr * lr + li * li);
    const float e1 = lbr - 1.f;
    const float qr = (e1 * lr + lbi * li) * den, qi = (lbi * lr - e1 * li) * den;
    const float* br = P.in[13] + (size_t)gi * 16; const float* bi = P.in[14] + (size_t)gi * 16;
#pragma unroll
    for (int q = 0; q < 4; ++q) {
      const f32x4 r4 = *(const f32x4*)(br + 4 * q), i4 = *(const f32x4*)(bi + 4 * q);
#pragma unroll
      for (int e = 0; e < 4; ++e) { bbr[4 * q + e] = qr * r4[e] - qi * i4[e]; bbi[4 * q + e] = qr * i4[e] + qi * r4[e]; }
    }
  }
  float sr = 0.f, si = 0.f;
  float* ends = (float*)(P.ws + WS_ENDS);
  if (mode == 2) { const size_t o = ((size_t)(l * 128 + b) * 32 + g) * 64 + n; sr = P.in[4][o]; si = P.in[5][o]; }
  else if (mode == 1 && c > 0) {
    float pr, pi;
    { const float mag = expf(lr * dt * 512.f); float sn, cs; sincos_rev((double)li * (double)dt * 512.0, sn, cs); pr = mag * cs; pi = mag * sn; }
    for (int c2 = 0; c2 < c; ++c2) {
      const float* e = ends + ((size_t)((b * 8 + c2) * 32 + g) * 64 + n) * 2;
      const float er = e[0], ei = e[1];
      const float nr = pr * sr - pi * si + er, ni = pr * si + pi * sr + ei;
      sr = nr; si = ni;
    }
  }
  const int ntok = mode == 2 ? 4 : 512;
  const size_t row0 = mode == 2 ? (size_t)(MP + b * 4) : (size_t)(b * 4096 + c * 512);
  const float* U = (const float*)(P.ws + WS_U);
  bf16_t* ssr = (bf16_t*)(P.ws + WS_SSR);
  float* ul = (float*)wl;
  unsigned* Sl = (unsigned*)(wl + 2048);
  bf16x8 cfrag[4]; f32x4 dsk = (f32x4){0.f, 0.f, 0.f, 0.f};
  if (mode >= 1) {
#pragma unroll
    for (int kk = 0; kk < 4; ++kk) {
      const size_t o = ((size_t)(l * 32 + g) * 16 + fr) * 64 + kk * 16 + fq * 4;
      const f32x4 cr = *(const f32x4*)(P.in[15] + o), ci = *(const f32x4*)(P.in[16] + o);
      u32x4 w; w.x = pk2(cr.x, -ci.x); w.y = pk2(cr.y, -ci.y); w.z = pk2(cr.z, -ci.z); w.w = pk2(cr.w, -ci.w);
      cfrag[kk] = as_bf16x8(w);
    }
    dsk = *(const f32x4*)(P.in[17] + l * 512 + g * 16 + fq * 4);
  } else {
#pragma unroll
    for (int kk = 0; kk < 4; ++kk) cfrag[kk] = as_bf16x8((u32x4){0u, 0u, 0u, 0u});
  }
  const int nsub = (ntok + 15) >> 4;
  f32x4 upre = (f32x4){0.f, 0.f, 0.f, 0.f};
  { const int tok = lane >> 2, seg = lane & 3; if (tok < ntok) upre = *(const f32x4*)(U + (row0 + tok) * 512 + g * 16 + seg * 4); }
  for (int sub = 0; sub < nsub; ++sub) {
    float* uc = ul + (sub & 1) * 256;
    *(f32x4*)(uc + lane * 4) = upre;
    if (sub + 1 < nsub) { const int tok = (sub + 1) * 16 + (lane >> 2), seg = lane & 3; upre = *(const f32x4*)(U + (row0 + tok) * 512 + g * 16 + seg * 4); }
    const int tmax = ntok - sub * 16 < 16 ? ntok - sub * 16 : 16;
#pragma unroll 4
    for (int tt = 0; tt < 16; ++tt) {
      if (tt < tmax) {
        const f32x4 u0 = *(const f32x4*)(uc + tt * 16), u1 = *(const f32x4*)(uc + tt * 16 + 4), u2 = *(const f32x4*)(uc + tt * 16 + 8), u3 = *(const f32x4*)(uc + tt * 16 + 12);
        float bur = 0.f, bui = 0.f;
#pragma unroll
        for (int e = 0; e < 4; ++e) {
          bur += u0[e] * bbr[e]; bui += u0[e] * bbi[e];
          bur += u1[e] * bbr[4 + e]; bui += u1[e] * bbi[4 + e];
          bur += u2[e] * bbr[8 + e]; bui += u2[e] * bbi[8 + e];
          bur += u3[e] * bbr[12 + e]; bui += u3[e] * bbi[12 + e];
        }
        const float nr = lbr * sr - lbi * si + bur, ni = lbr * si + lbi * sr + bui;
        sr = nr; si = ni;
        if (mode >= 1) Sl[tt * 68 + n] = pk2(sr, si);
      }
    }
    if (mode >= 1) {
      f32x4 acc = (f32x4){0.f, 0.f, 0.f, 0.f};
#pragma unroll
      for (int kk = 0; kk < 4; ++kk) {
        const u32x4 sv = *(const u32x4*)(Sl + fr * 68 + kk * 16 + fq * 4);
        acc = MFMA16(cfrag[kk], as_bf16x8(sv), acc);
      }
      if (fr < tmax) {
        const f32x4 u4 = *(const f32x4*)(uc + fr * 16 + fq * 4);
        float y[4];
#pragma unroll
        for (int j = 0; j < 4; ++j) {
          const float x = acc[j] + dsk[j] * u4[j];
          const float z2 = 1.5957691216057308f * (x + 0.044715f * x * x * x);
          y[j] = x / (1.f + __expf(-z2));
        }
        u32x2 ov; ov.x = pk2(y[0], y[1]); ov.y = pk2(y[2], y[3]);
        *(u32x2*)(ssr + (row0 + sub * 16 + fr) * 512 + g * 16 + fq * 4) = ov;
      }
    }
  }
  if (mode == 0) { float* e = ends + ((size_t)((b * 8 + c) * 32 + g) * 64 + n) * 2; e[0] = sr; e[1] = si; }
  else if (mode == 1) { if (c == 7) { const size_t o = ((size_t)(l * 8 + b) * 32 + g) * 64 + n; P.out[O_RP + o] = sr; P.out[O_IP + o] = si; } }
  else { const size_t o = ((size_t)(l * 128 + b) * 32 + g) * 64 + n; P.out[O_RS + o] = sr; P.out[O_IS + o] = si; }
}

DI void merge_phase(CParams& P, int l) {
  const int tid = tid_opq(); const int wid = tid >> 6, lane = tid & 63;
  const bf16_t* attn = (const bf16_t*)(P.ws + WS_ATT);
  const bf16_t* ss2 = (const bf16_t*)(P.ws + WS_SS2);
  bf16_t* h = (bf16_t*)(P.ws + WS_H);
  const float* ga = P.in[20] + l * 512 + lane * 8;
  const float* gs = P.in[21] + l * 512 + lane * 8;
  const f32x4 ga0 = *(const f32x4*)ga, ga1 = *(const f32x4*)(ga + 4), gs0 = *(const f32x4*)gs, gs1 = *(const f32x4*)(gs + 4);
  for (int r = blockIdx.x * 8 + wid; r < MT; r += gridDim.x * 8) {
    const u32x4 av = *(const u32x4*)(attn + (size_t)r * 512 + lane * 8);
    const u32x4 sv = *(const u32x4*)(ss2 + (size_t)r * 512 + lane * 8);
    float a[8], s[8]; float qa = 0.f, qs = 0.f;
#pragma unroll
    for (int e = 0; e < 4; ++e) { a[2 * e] = bflo(av[e]); a[2 * e + 1] = bfhi(av[e]); s[2 * e] = bflo(sv[e]); s[2 * e + 1] = bfhi(sv[e]); }
#pragma unroll
    for (int e = 0; e < 8; ++e) { qa += a[e] * a[e]; qs += s[e] * s[e]; }
    qa = wave_sum(qa, lane); qs = wave_sum(qs, lane);
    const float ra = rsqrtf(qa * (1.f / 512.f) + EPS), rs = rsqrtf(qs * (1.f / 512.f) + EPS);
    u32x4 oa, os;
    oa.x = pk2(a[0] * ra * ga0.x, a[1] * ra * ga0.y); oa.y = pk2(a[2] * ra * ga0.z, a[3] * ra * ga0.w);
    oa.z = pk2(a[4] * ra * ga1.x, a[5] * ra * ga1.y); oa.w = pk2(a[6] * ra * ga1.z, a[7] * ra * ga1.w);
    os.x = pk2(s[0] * rs * gs0.x, s[1] * rs * gs0.y); os.y = pk2(s[2] * rs * gs0.z, s[3] * rs * gs0.w);
    os.z = pk2(s[4] * rs * gs1.x, s[5] * rs * gs1.y); os.w = pk2(s[6] * rs * gs1.z, s[7] * rs * gs1.w);
    *(u32x4*)(h + (size_t)r * 1024 + lane * 8) = oa;
    *(u32x4*)(h + (size_t)r * 1024 + 512 + lane * 8) = os;
  }
}

#ifndef SKIP_MASK
#define SKIP_MASK 0
#endif
#define PH(x) if constexpr (!((SKIP_MASK >> (x)) & 1))
template <int l>
DI void layer_body(CParams* kp, char* shm, cg::grid_group& grid) {
#define P (*launder(kp))
  const int nblk = gridDim.x;
  bf16_t* wt0 = (bf16_t*)(P.ws + WS_WT);
  bf16_t* hbuf = (bf16_t*)(P.ws + WS_H);
  float* xcur = (float*)(P.ws + WS_X);

    const bf16_t* wt = wt0 + (size_t)l * WT_LAYER;
    PH(1) {
      EpiIn e; e.l = l; e.qkv = (bf16_t*)(P.ws + WS_QKV); e.u = (float*)(P.ws + WS_U); e.out = P.out;
      gemm_phase(hbuf, wt + WT_IN, 130, 5, 1024, e, shm);
    }
    grid.sync();
    {
      PH(2) for (int u = blockIdx.x; u < 512; u += nblk) attn_prompt_unit(P, l, u, shm);
      PH(3) for (int u = blockIdx.x; u < 256; u += nblk) attn_sample_unit(P, l, u, shm);
      const int tq = tid_opq(); const int wv = __builtin_amdgcn_readfirstlane(tq >> 6), lane = tq & 63;
      PH(4) for (int it = blockIdx.x * 8 + wv; it < 2048; it += nblk * 8) s5_item(P, l, 0, it, shm + wv * 6656, lane);
    }
    grid.sync();
    {
      const int tq = tid_opq(); const int wv = __builtin_amdgcn_readfirstlane(tq >> 6), lane = tq & 63;
      PH(5) for (int it = blockIdx.x * 8 + wv; it < 2048; it += nblk * 8) s5_item(P, l, 1, it, shm + wv * 6656, lane);
      PH(6) for (int it = blockIdx.x * 8 + wv; it < 4096; it += nblk * 8) s5_item(P, l, 2, it, shm + wv * 6656, lane);
    }
    grid.sync();
    PH(7) {
      EpiGlu e; e.ssr = (const bf16_t*)(P.ws + WS_SSR); e.ss2 = (bf16_t*)(P.ws + WS_SS2); e.bias = P.in[19] + l * 512;
      gemm_phase((const bf16_t*)(P.ws + WS_SSR), wt + WT_GLU, 130, 2, 512, e, shm);
    }
    grid.sync();
    PH(8) merge_phase(P, l);
    grid.sync();
    PH(9) {
      EpiRes e; e.xp = P.in[0]; e.xs = P.in[1]; e.xcur = xcur; e.from_in = (l == 0);
      gemm_phase(hbuf, wt + WT_OUT, 130, 4, 1024, e, shm);
    }
    grid.sync();
    PH(10) norm_phase(P, 1, P.in[23] + l * 1024);
    grid.sync();
    PH(11) {
      EpiUp e; e.l = l; e.act = (bf16_t*)(P.ws + WS_ACT); e.halo = (float*)(P.ws + WS_HALO); e.ups = (float*)(P.ws + WS_UPS);
      e.conv_w = P.in[25]; e.conv_b = P.in[26]; e.out = P.out;
      gemm_phase(hbuf, wt + WT_UP, 130, 21, 1024, e, shm);
    }
    grid.sync();
    PH(12) fixup_phase(P, l);
    grid.sync();
    PH(13) {
      EpiRes e; e.xp = P.in[0]; e.xs = P.in[1]; e.xcur = xcur; e.from_in = 0;
      gemm_phase((const bf16_t*)(P.ws + WS_ACT), wt + WT_DOWN, 130, 4, 2688, e, shm);
    }
    grid.sync();
    if (l == 0) { norm_phase(P, 1, P.in[7] + 1024); grid.sync(); }
    else final_norm_phase(P);
#undef P
}
__global__ void __launch_bounds__(512) mega(Params Parg) {
  extern __shared__ __attribute__((aligned(16))) char shm[];
  CParams* kp = (CParams*)__builtin_amdgcn_kernarg_segment_ptr();
  cg::grid_group grid = cg::this_grid();
  PH(0) phase0(*launder(kp), shm);
  grid.sync();
  layer_body<0>(kp, shm, grid);
  layer_body<1>(kp, shm, grid);
}
extern "C" void kernel_launch(void* const* d_in, const int* in_sizes, int n_in, void* d_out, int out_size, void* d_ws, size_t ws_size, hipStream_t stream) {
  static int grid_blocks = 0;
  if (grid_blocks == 0) {
    if (n_in != 29 || ws_size < WS_TOTAL) { fprintf(stderr, "kernel_launch: unexpected n_in %d or ws_size %zu (< %zu)\n", n_in, ws_size, (size_t)WS_TOTAL); grid_blocks = -1; return; }
    int dev = 0, cus = 0, per_cu = 0;
    hipGetDevice(&dev);
    hipDeviceGetAttribute(&cus, hipDeviceAttributeMultiprocessorCount, dev);
    hipFuncSetAttribute((const void*)mega, hipFuncAttributeMaxDynamicSharedMemorySize, LDS_BYTES);
    hipOccupancyMaxActiveBlocksPerMultiprocessor(&per_cu, (const void*)mega, 512, LDS_BYTES);
    if (per_cu < 1) per_cu = 1;
    if (per_cu > 1) per_cu = 1;
    grid_blocks = cus * per_cu;
  }
  if (grid_blocks < 0) return;
  Params p{};
  for (int i = 0; i < 29; ++i) p.in[i] = (const float*)d_in[i];
  p.out = (float*)d_out;
  p.ws = (char*)d_ws;
  void* args[] = {&p};
  hipError_t e = hipLaunchCooperativeKernel((const void*)mega, dim3(grid_blocks), dim3(512), args, LDS_BYTES, stream);
  if (e != hipSuccess) fprintf(stderr, "cooperative launch failed: %s (grid %d)\n", hipGetErrorString(e), grid_blocks);
}
```

```cpp
#include <hip/hip_runtime.h>
#include <hip/hip_cooperative_groups.h>
#include <cstdint>
#include <cstdio>
namespace cg = cooperative_groups;

#define DI __device__ __forceinline__
typedef unsigned short bf16_t;
typedef short bf16x8 __attribute__((ext_vector_type(8)));
typedef float f32x4 __attribute__((ext_vector_type(4)));
typedef unsigned u32x4 __attribute__((ext_vector_type(4)));
typedef unsigned u32x2 __attribute__((ext_vector_type(2)));

constexpr int MP = 32768, MT = 33280;
constexpr float EPS = 1e-5f;
constexpr float LOG2E = 1.4426950408889634f;

constexpr size_t O_Y = 0, O_KP = 34078720, O_VP = 34340864, O_RP = 34603008, O_IP = 34635776, O_CP = 34668544,
                 O_KS = 34840576, O_VS = 39034880, O_RS = 43229184, O_IS = 43753472, O_CS = 44277760;
constexpr size_t WS_WT = 0, WS_H = 43515904, WS_X = 111673344, WS_R = 247988224;
constexpr size_t WS_QKV = WS_R, WS_U = WS_R + 51118080, WS_ATT = WS_R + 119275520, WS_SSR = WS_R + 153354240, WS_SS2 = WS_R + 187432960;
constexpr size_t WS_ACT = WS_R;
constexpr size_t WS_HALO = 469499904, WS_UPS = 480509952, WS_ENDS = 491520000, WS_TOTAL = 492568576;
constexpr size_t WT_IN = 0, WT_GLU = 1310720, WT_OUT = 1572864, WT_UP = 2621440, WT_DOWN = 8126464, WT_LAYER = 10878976;
constexpr int LDS_BYTES = 136 * 1024;

struct Params {
  const float* in[29];
  float* out;
  char* ws;
};

typedef const __attribute__((address_space(4))) Params CParams;
DI CParams* launder(CParams* p) { asm volatile("" : "+s"(p)); return p; }
DI unsigned pk2(float lo, float hi) { unsigned r; asm("v_cvt_pk_bf16_f32 %0, %1, %2" : "=v"(r) : "v"(lo), "v"(hi)); return r; }
DI float bflo(unsigned u) { return __uint_as_float(u << 16); }
DI float bfhi(unsigned u) { return __uint_as_float(u & 0xffff0000u); }
DI float bf2f(bf16_t b) { return __uint_as_float(((unsigned)b) << 16); }
DI float shx(float v, int o, int lane) { return __int_as_float(__builtin_amdgcn_ds_bpermute((lane ^ o) << 2, __float_as_int(v))); }
DI float wave_sum(float v, int lane) {
#pragma unroll
  for (int o = 1; o < 64; o <<= 1) v += shx(v, o, lane);
  return v;
}
DI int tid_opq() { int t = threadIdx.x; asm volatile("" : "+v"(t)); return t; }
DI bf16x8 as_bf16x8(u32x4 v) { return __builtin_bit_cast(bf16x8, v); }
#define MFMA16(a, b, c) __builtin_amdgcn_mfma_f32_16x16x32_bf16((a), (b), (c), 0, 0, 0)

DI void transpose_item(const float* __restrict__ W, int K, int N, bf16_t* __restrict__ WT, int item, float* scr, int tid, bool perm_up) {
  const int nblk = N / 64, kb = item / nblk, nb = item % nblk, k0 = kb * 64, n0 = nb * 64;
  int src_n0 = n0;
  if (perm_up) { const int tile = n0 >> 8, j = n0 & 255; src_n0 = (j < 128) ? tile * 128 + j : 2688 + tile * 128 + (j - 128); }
#pragma unroll
  for (int i = 0; i < 8; ++i) { const int kk = (tid >> 6) + 8 * i, nn = tid & 63; scr[kk * 65 + nn] = W[(size_t)(k0 + kk) * N + src_n0 + nn]; }
  __syncthreads();
  {
    const int nn = tid >> 3, c = tid & 7;
    const float* s = scr + (8 * c) * 65 + nn;
    u32x4 o;
    o.x = pk2(s[0 * 65], s[1 * 65]); o.y = pk2(s[2 * 65], s[3 * 65]); o.z = pk2(s[4 * 65], s[5 * 65]); o.w = pk2(s[6 * 65], s[7 * 65]);
    *(u32x4*)(WT + (size_t)(n0 + nn) * K + k0 + 8 * c) = o;
  }
  __syncthreads();
}

DI void norm_row_bf16(const float* __restrict__ xr, const float* __restrict__ g, bf16_t* __restrict__ orow, int lane) {
  f32x4 v[4]; float s = 0.f;
#pragma unroll
  for (int j = 0; j < 4; ++j) { v[j] = ((const f32x4*)xr)[lane + 64 * j]; s += v[j].x * v[j].x + v[j].y * v[j].y + v[j].z * v[j].z + v[j].w * v[j].w; }
  s = wave_sum(s, lane);
  const float rstd = rsqrtf(s * (1.f / 1024.f) + EPS);
#pragma unroll
  for (int j = 0; j < 4; ++j) {
    const f32x4 gg = ((const f32x4*)g)[lane + 64 * j];
    u32x2 o; o.x = pk2(v[j].x * rstd * gg.x, v[j].y * rstd * gg.y); o.y = pk2(v[j].z * rstd * gg.z, v[j].w * rstd * gg.w);
    ((u32x2*)orow)[lane + 64 * j] = o;
  }
}
DI void norm_row_f32(const float* __restrict__ xr, const float* __restrict__ g, float* __restrict__ orow, int lane) {
  f32x4 v[4]; float s = 0.f;
#pragma unroll
  for (int j = 0; j < 4; ++j) { v[j] = ((const f32x4*)xr)[lane + 64 * j]; s += v[j].x * v[j].x + v[j].y * v[j].y + v[j].z * v[j].z + v[j].w * v[j].w; }
  s = wave_sum(s, lane);
  const float rstd = rsqrtf(s * (1.f / 1024.f) + EPS);
#pragma unroll
  for (int j = 0; j < 4; ++j) {
    const f32x4 gg = ((const f32x4*)g)[lane + 64 * j];
    f32x4 o; o.x = v[j].x * rstd * gg.x; o.y = v[j].y * rstd * gg.y; o.z = v[j].z * rstd * gg.z; o.w = v[j].w * rstd * gg.w;
    ((f32x4*)orow)[lane + 64 * j] = o;
  }
}
DI const float* xrow_in(CParams& P, int r) { return r < MP ? P.in[0] + (size_t)r * 1024 : P.in[1] + (size_t)(r - MP) * 1024; }

DI void norm_phase(CParams& P, int mode, const float* g) {
  const int tid = tid_opq(); const int wid = tid >> 6, lane = tid & 63;
  const float* xcur = (const float*)(P.ws + WS_X);
  bf16_t* h = (bf16_t*)(P.ws + WS_H);
  for (int r = blockIdx.x * 8 + wid; r < MT; r += gridDim.x * 8) {
    const float* xr = mode == 0 ? xrow_in(P, r) : xcur + (size_t)r * 1024;
    norm_row_bf16(xr, g, h + (size_t)r * 1024, lane);
  }
}
DI void final_norm_phase(CParams& P) {
  const int tid = tid_opq(); const int wid = tid >> 6, lane = tid & 63;
  const float* xcur = (const float*)(P.ws + WS_X);
  for (int r = blockIdx.x * 8 + wid; r < MT; r += gridDim.x * 8)
    norm_row_f32(xcur + (size_t)r * 1024, P.in[28], P.out + O_Y + (size_t)r * 1024, lane);
}

DI void phase0(CParams& P, char* shm) {
  const int tid = tid_opq();
  constexpr int per_layer = 320 + 64 + 256 + 1344 + 672;
  bf16_t* wt0 = (bf16_t*)(P.ws + WS_WT);
  for (int it = blockIdx.x; it < 2 * per_layer; it += gridDim.x) {
    const int l = it / per_layer; int r = it % per_layer;
    bf16_t* wt = wt0 + (size_t)l * WT_LAYER;
    if (r < 320) { transpose_item(P.in[8] + (size_t)l * 1024 * 1280, 1024, 1280, wt + WT_IN, r, (float*)shm, tid, false); continue; }
    r -= 320;
    if (r < 64) { transpose_item(P.in[18] + (size_t)l * 512 * 512, 512, 512, wt + WT_GLU, r, (float*)shm, tid, false); continue; }
    r -= 64;
    if (r < 256) { transpose_item(P.in[22] + (size_t)l * 1024 * 1024, 1024, 1024, wt + WT_OUT, r, (float*)shm, tid, false); continue; }
    r -= 256;
    if (r < 1344) { transpose_item(P.in[24] + (size_t)l * 1024 * 5376, 1024, 5376, wt + WT_UP, r, (float*)shm, tid, true); continue; }
    r -= 1344;
    transpose_item(P.in[27] + (size_t)l * 2688 * 1024, 2688, 1024, wt + WT_DOWN, r, (float*)shm, tid, false);
  }
  norm_phase(P, 0, P.in[7]);
}

DI int lds_byte(int r, int c) { const int st = (r >> 4) * 2 + (c >> 5), rr = r & 15, cc = c & 31, ob = rr * 64 + cc * 2; return st * 1024 + (ob ^ (((ob >> 9) & 1) << 5)); }
DI void stage_rc(int b, int& R, int& C) { const int st = b / 1024, sb = b % 1024, swz = sb ^ (((sb >> 9) & 1) << 5); R = (st >> 1) * 16 + swz / 64; C = (st & 1) * 32 + (swz % 64) / 2; }
DI void gl_lds16(const void* g, void* l) {
  __builtin_amdgcn_global_load_lds((const __attribute__((address_space(1))) void*)g, (__attribute__((address_space(3))) void*)l, 16, 0, 0);
}

template <class Epi>
DI void gemm_phase(const bf16_t* __restrict__ A, const bf16_t* __restrict__ Bt, int nM, int nN, int K, const Epi& epi, char* shm) {
  const int tid = tid_opq(); const int wid = tid >> 6, lane = tid & 63, wr = wid >> 2, wc = wid & 3, fr = lane & 15, fq = lane >> 4;
  const int nt = K / 64, ntiles = nM * nN;
  int sr0, sc0, sr1, sc1; stage_rc(tid * 16, sr0, sc0); stage_rc(tid * 16 + 8192, sr1, sc1);
  const unsigned go0 = (unsigned)(sr0 * K + sc0) * 2u, go1 = (unsigned)(sr1 * K + sc1) * 2u;
  const unsigned goh = (unsigned)(128 * K) * 2u;
  const int lob = fr * 64 + fq * 16;
  const int lswz = lob ^ (((lob >> 9) & 1) << 5);
  char* const a_base = shm + lswz + wr * 8192;
  char* const b_base = shm + 65536 + lswz + wc * 4096;
  char* const st_base = shm + tid * 16;
  for (int tile = blockIdx.x; tile < ntiles; tile += gridDim.x) {
    const int pm = tile / nN, pn = tile % nN;
    const char* Ab = (const char*)(A + (size_t)pm * 256 * K);
    const char* Bb = (const char*)(Bt + (size_t)pn * 256 * K);
    f32x4 acc[2][2][4][2];
#pragma unroll
    for (int a = 0; a < 2; ++a)
#pragma unroll
      for (int b = 0; b < 2; ++b)
#pragma unroll
        for (int m = 0; m < 4; ++m)
#pragma unroll
          for (int n = 0; n < 2; ++n) acc[a][b][m][n] = (f32x4){0.f, 0.f, 0.f, 0.f};

#define GEMM_STAGE(buf, kt)                                                         \
  do {                                                                              \
    const char* ak_ = Ab + (size_t)(kt) * 128;                                      \
    const char* bk_ = Bb + (size_t)(kt) * 128;                                      \
    char* la_ = st_base + (buf) * 32768;                                            \
    gl_lds16(ak_ + go0, la_);                                                       \
    gl_lds16(ak_ + go1, la_ + 8192);                                                \
    gl_lds16(ak_ + goh + go0, la_ + 16384);                                         \
    gl_lds16(ak_ + goh + go1, la_ + 16384 + 8192);                                  \
    gl_lds16(bk_ + go0, la_ + 65536);                                               \
    gl_lds16(bk_ + go1, la_ + 65536 + 8192);                                        \
    gl_lds16(bk_ + goh + go0, la_ + 65536 + 16384);                                 \
    gl_lds16(bk_ + goh + go1, la_ + 65536 + 16384 + 8192);                          \
  } while (0)

    GEMM_STAGE(0, 0);
    asm volatile("s_waitcnt vmcnt(0)" ::: "memory");
    __syncthreads();
    for (int t = 0; t < nt; ++t) {
      const int cur = t & 1;
      if (t + 1 < nt) GEMM_STAGE(cur ^ 1, t + 1);
      const char* ac = a_base + cur * 32768;
      const char* bc = b_base + cur * 32768;
      bf16x8 Bf[2][2][2];
#pragma unroll
      for (int bj = 0; bj < 2; ++bj)
#pragma unroll
        for (int n = 0; n < 2; ++n)
#pragma unroll
          for (int k = 0; k < 2; ++k) Bf[bj][n][k] = *(const bf16x8*)(bc + bj * 16384 + n * 2048 + k * 1024);
#pragma unroll
      for (int ai = 0; ai < 2; ++ai) {
        bf16x8 At[4][2];
        if (ai == 1) __builtin_amdgcn_sched_barrier(0);
#pragma unroll
        for (int m = 0; m < 4; ++m)
#pragma unroll
          for (int k = 0; k < 2; ++k) At[m][k] = *(const bf16x8*)(ac + ai * 16384 + m * 2048 + k * 1024);
#pragma unroll
        for (int bj = 0; bj < 2; ++bj)
#pragma unroll
          for (int m = 0; m < 4; ++m)
#pragma unroll
            for (int n = 0; n < 2; ++n)
#pragma unroll
              for (int k = 0; k < 2; ++k) acc[ai][bj][m][n] = MFMA16(Bf[bj][n][k], At[m][k], acc[ai][bj][m][n]);
      }
      asm volatile("s_waitcnt vmcnt(0)" ::: "memory");
      __syncthreads();
    }
    {
      int wr_ = wr, wc_ = wc, fr_ = fr, fq_ = fq;
      asm volatile("" : "+v"(wr_), "+v"(wc_), "+v"(fr_), "+v"(fq_));
      epi(acc, pm, pn, wr_, wc_, fr_, fq_, shm);
    }
  }
}

template <class Epi>
DI void gemm_phase8(const bf16_t* __restrict__ A, const bf16_t* __restrict__ Bt, int nM, int nN, int K, const Epi& epi, char* shm) {
  const int tid = tid_opq(); const int wid = tid >> 6, lane = tid & 63, wr = wid >> 2, wc = wid & 3, fr = lane & 15, fq = lane >> 4;
  const int nt = K / 64, ntiles = nM * nN;
  int sr0, sc0, sr1, sc1; stage_rc(tid * 16, sr0, sc0); stage_rc(tid * 16 + 8192, sr1, sc1);
  const unsigned go0 = (unsigned)(sr0 * K + sc0) * 2u, go1 = (unsigned)(sr1 * K + sc1) * 2u;
  const unsigned goh = (unsigned)(128 * K) * 2u;
  const int lob = fr * 64 + fq * 16;
  const int lswz = lob ^ (((lob >> 9) & 1) << 5);
  char* const a_base = shm + lswz + wr * 8192;
  char* const b_base = shm + 65536 + lswz + wc * 4096;
  const int wave_s = __builtin_amdgcn_readfirstlane(wid);
  char* const st_base = shm + wave_s * 1024;
#define SA8(b, h) (((b) * 2 + (h)) * 16384)
#define SB8(b, h) ((4 + (b) * 2 + (h)) * 16384)
#define STG8(ldsoff, panel, kt) do { const char* g_ = (panel) + (size_t)(kt) * 128; asm volatile("" : "+s"(g_)); gl_lds16(g_ + go0, st_base + (ldsoff)); gl_lds16(g_ + go1, st_base + (ldsoff) + 8192); } while (0)
#define LDA8(dst, b, h) _Pragma("unroll") for (int m = 0; m < 4; ++m) _Pragma("unroll") for (int k = 0; k < 2; ++k) dst[m][k] = *(const bf16x8*)(a_base + SA8(b, h) + m * 2048 + k * 1024)
#define LDB8(dst, b, h) _Pragma("unroll") for (int n = 0; n < 2; ++n) _Pragma("unroll") for (int k = 0; k < 2; ++k) dst[n][k] = *(const bf16x8*)(b_base + ((b) * 2 + (h)) * 16384 + n * 2048 + k * 1024)
#define MMA8(ai, bj, Ax, Bx) do { __builtin_amdgcn_s_setprio(1); \
    _Pragma("unroll") for (int m = 0; m < 4; ++m) _Pragma("unroll") for (int n = 0; n < 2; ++n) _Pragma("unroll") for (int k = 0; k < 2; ++k) \
      acc[ai][bj][m][n] = MFMA16(Bx[n][k], Ax[m][k], acc[ai][bj][m][n]); \
    __builtin_amdgcn_s_setprio(0); } while (0)
#define WAIT_V(n) asm volatile("s_waitcnt vmcnt(" #n ")" ::: "memory")
#define WAIT_L(n) asm volatile("s_waitcnt lgkmcnt(" #n ")" ::: "memory")
#define BAR8 __builtin_amdgcn_s_barrier()
#define SCHED8 __builtin_amdgcn_sched_barrier(0)
  for (int tile = blockIdx.x; tile < ntiles; tile += gridDim.x) {
    const int pm = tile / nN, pn = tile % nN;
    const char* A0 = (const char*)(A + (size_t)pm * 256 * K);
    const char* A1 = A0 + goh;
    const char* B0p = (const char*)(Bt + (size_t)pn * 256 * K);
    const char* B1p = B0p + goh;
    f32x4 acc[2][2][4][2];
#pragma unroll
    for (int a = 0; a < 2; ++a)
#pragma unroll
      for (int b = 0; b < 2; ++b)
#pragma unroll
        for (int m = 0; m < 4; ++m)
#pragma unroll
          for (int n = 0; n < 2; ++n) acc[a][b][m][n] = (f32x4){0.f, 0.f, 0.f, 0.f};
    bf16x8 At[4][2], Bx0[2][2], Bx1[2][2];
    STG8(SB8(0, 0), B0p, 0); STG8(SA8(0, 0), A0, 0); STG8(SB8(0, 1), B1p, 0); STG8(SA8(0, 1), A1, 0);
    if (wr == 1) BAR8;
    WAIT_V(4); BAR8;
    STG8(SB8(1, 0), B0p, 1); STG8(SA8(1, 0), A0, 1); STG8(SB8(1, 1), B1p, 1);
    WAIT_V(6); BAR8;
    for (int t = 0; t < nt - 2; t += 2) {
      LDB8(Bx0, 0, 0); SCHED8; LDA8(At, 0, 0); STG8(SA8(1, 1), A1, t + 1);
      WAIT_L(8); BAR8; WAIT_L(0); MMA8(0, 0, At, Bx0); BAR8; SCHED8;
      LDB8(Bx1, 0, 1); STG8(SB8(0, 0), B0p, t + 2);
      BAR8; WAIT_L(0); MMA8(0, 1, At, Bx1); BAR8;
      LDA8(At, 0, 1); STG8(SA8(0, 0), A0, t + 2);
      BAR8; WAIT_L(0); MMA8(1, 0, At, Bx0); BAR8; SCHED8;
      STG8(SB8(0, 1), B1p, t + 2);
      WAIT_V(6); BAR8; MMA8(1, 1, At, Bx1); BAR8;
      LDB8(Bx0, 1, 0); SCHED8; LDA8(At, 1, 0); STG8(SA8(0, 1), A1, t + 2);
      WAIT_L(8); BAR8; WAIT_L(0); MMA8(0, 0, At, Bx0); BAR8; SCHED8;
      LDB8(Bx1, 1, 1); STG8(SB8(1, 0), B0p, t + 3);
      BAR8; WAIT_L(0); MMA8(0, 1, At, Bx1); BAR8;
      LDA8(At, 1, 1); STG8(SA8(1, 0), A0, t + 3);
      BAR8; WAIT_L(0); MMA8(1, 0, At, Bx0); BAR8; SCHED8;
      STG8(SB8(1, 1), B1p, t + 3);
      WAIT_V(6); BAR8; MMA8(1, 1, At, Bx1); BAR8;
    }
    { LDB8(Bx0, 0, 0); LDA8(At, 0, 0); STG8(SA8(1, 1), A1, nt - 1);
      BAR8; WAIT_L(0); MMA8(0, 0, At, Bx0); BAR8;
      LDB8(Bx1, 0, 1); BAR8; WAIT_L(0); MMA8(0, 1, At, Bx1); BAR8;
      LDA8(At, 0, 1); WAIT_V(4); BAR8; WAIT_L(0); MMA8(1, 0, At, Bx0); MMA8(1, 1, At, Bx1); BAR8; }
    { LDB8(Bx0, 1, 0); LDA8(At, 1, 0); WAIT_V(2); BAR8; WAIT_L(0); MMA8(0, 0, At, Bx0); BAR8;
      LDB8(Bx1, 1, 1); WAIT_V(0); BAR8; WAIT_L(0); MMA8(0, 1, At, Bx1); BAR8;
      LDA8(At, 1, 1); BAR8; WAIT_L(0); MMA8(1, 0, At, Bx0); MMA8(1, 1, At, Bx1); BAR8; }
    if (wr == 0) BAR8;
    {
      int wr_ = wr, wc_ = wc, fr_ = fr, fq_ = fq;
      asm volatile("" : "+v"(wr_), "+v"(wc_), "+v"(fr_), "+v"(fq_));
      epi(acc, pm, pn, wr_, wc_, fr_, fq_, shm);
    }
  }
}

struct EpiIn {
  int l; bf16_t* qkv; float* u; float* out;
  DI void operator()(const f32x4 (&acc)[2][2][4][2], int pm, int pn, int wr, int wc, int fr, int fq, char*) const {
#pragma unroll
    for (int ai = 0; ai < 2; ++ai)
#pragma unroll
      for (int m = 0; m < 4; ++m) {
        const int row = pm * 256 + ai * 128 + wr * 64 + m * 16 + fr;
#pragma unroll
        for (int bj = 0; bj < 2; ++bj)
#pragma unroll
          for (int n = 0; n < 2; ++n) {
            const int col = pn * 256 + bj * 128 + wc * 32 + n * 16 + fq * 4;
            const f32x4 v = acc[ai][bj][m][n];
            if (col < 768) {
              u32x2 o; o.x = pk2(v.x, v.y); o.y = pk2(v.z, v.w);
              *(u32x2*)(qkv + (size_t)row * 768 + col) = o;
              if (col >= 512) {
                const bool isk = col < 640; const int cc = col - (isk ? 512 : 640);
                if (row < MP) {
                  const int t = row & 4095, b = row >> 12;
                  if (t >= 3968) *(f32x4*)(out + (isk ? O_KP : O_VP) + ((size_t)((l * 8 + b) * 128 + (t - 3968))) * 128 + cc) = v;
                } else {
                  const int rs = row - MP, b = rs >> 2, t = rs & 3;
                  *(f32x4*)(out + (isk ? O_KS : O_VS) + ((size_t)((l * 128 + b) * 128 + 124 + t)) * 128 + cc) = v;
                }
              }
            } else {
              *(f32x4*)(u + (size_t)row * 512 + (col - 768)) = v;
            }
          }
      }
  }
};
struct EpiGlu {
  const bf16_t* ssr; bf16_t* ss2; const float* bias;
  DI void operator()(const f32x4 (&acc)[2][2][4][2], int pm, int pn, int wr, int wc, int fr, int fq, char*) const {
#pragma unroll
    for (int ai = 0; ai < 2; ++ai)
#pragma unroll
      for (int m = 0; m < 4; ++m) {
        const int row = pm * 256 + ai * 128 + wr * 64 + m * 16 + fr;
#pragma unroll
        for (int bj = 0; bj < 2; ++bj)
#pragma unroll
          for (int n = 0; n < 2; ++n) {
            const int col = pn * 256 + bj * 128 + wc * 32 + n * 16 + fq * 4;
            const f32x4 v = acc[ai][bj][m][n];
            asm volatile("" ::: "memory");
            const f32x4 bb = *(const f32x4*)(bias + col);
            const u32x2 sv = *(const u32x2*)(ssr + (size_t)row * 512 + col);
            const float s0 = bflo(sv.x), s1 = bfhi(sv.x), s2 = bflo(sv.y), s3 = bfhi(sv.y);
            const float o0 = s0 / (1.f + __expf(-(v.x + bb.x))), o1 = s1 / (1.f + __expf(-(v.y + bb.y)));
            const float o2 = s2 / (1.f + __expf(-(v.z + bb.z))), o3 = s3 / (1.f + __expf(-(v.w + bb.w)));
            u32x2 o; o.x = pk2(o0, o1); o.y = pk2(o2, o3);
            *(u32x2*)(ss2 + (size_t)row * 512 + col) = o;
          }
      }
  }
};
struct EpiRes {
  const float* xp; const float* xs; float* xcur; int from_in;
  DI void operator()(const f32x4 (&acc)[2][2][4][2], int pm, int pn, int wr, int wc, int fr, int fq, char*) const {
#pragma unroll
    for (int ai = 0; ai < 2; ++ai)
#pragma unroll
      for (int m = 0; m < 4; ++m) {
        const int row = pm * 256 + ai * 128 + wr * 64 + m * 16 + fr;
        const float* src = from_in ? (row < MP ? xp + (size_t)row * 1024 : xs + (size_t)(row - MP) * 1024) : xcur + (size_t)row * 1024;
        asm volatile("" ::: "memory");
#pragma unroll
        for (int bj = 0; bj < 2; ++bj)
#pragma unroll
          for (int n = 0; n < 2; ++n) {
            const int col = pn * 256 + bj * 128 + wc * 32 + n * 16 + fq * 4;
            const f32x4 x = *(const f32x4*)(src + col);
            *(f32x4*)(xcur + (size_t)row * 1024 + col) = x + acc[ai][bj][m][n];
          }
      }
  }
};
struct EpiUp {
  int l; bf16_t* act; float* halo; float* ups; const float* conv_w; const float* conv_b; float* out;
  DI void operator()(const f32x4 (&acc)[2][2][4][2], int pm, int pn, int wr, int wc, int fr, int fq, char* shm) const {
    const int chb = pn * 128;
    if (pm >= 128) {
#pragma unroll
      for (int ai = 0; ai < 2; ++ai)
#pragma unroll
        for (int m = 0; m < 4; ++m) {
          const int rs = (pm - 128) * 256 + ai * 128 + wr * 64 + m * 16 + fr;
#pragma unroll
          for (int bj = 0; bj < 2; ++bj)
#pragma unroll
            for (int n = 0; n < 2; ++n) {
              const int c = wc * 32 + n * 16 + fq * 4;
              *(f32x4*)(ups + (size_t)rs * 5376 + (bj ? 2688 : 0) + chb + c) = acc[ai][bj][m][n];
            }
        }
      return;
    }
    bf16_t* S = (bf16_t*)shm;
#pragma unroll
    for (int ai = 0; ai < 2; ++ai)
#pragma unroll
      for (int m = 0; m < 4; ++m) {
        const int R = ai * 128 + wr * 64 + m * 16 + fr;
#pragma unroll
        for (int bj = 0; bj < 2; ++bj)
#pragma unroll
          for (int n = 0; n < 2; ++n) {
            const int c = wc * 32 + n * 16 + fq * 4;
            const f32x4 v = acc[ai][bj][m][n];
            u32x2 o; o.x = pk2(v.x, v.y); o.y = pk2(v.z, v.w);
            *(u32x2*)(S + R * 264 + bj * 128 + c) = o;
            if (((ai == 0 && m == 0) || (ai == 1 && m == 3)) && (R < 2 || R >= 254)) {
              const int hr = R < 2 ? R : R - 252;
              const int oc = (bj ? 2688 : 0) + chb + c;
              *(f32x4*)(halo + ((size_t)(pm * 4 + hr)) * 5376 + oc) = v;
              if (R >= 254 && (pm & 15) == 15) *(f32x4*)(out + O_CP + ((size_t)((l * 8 + (pm >> 4)) * 2 + (R - 254))) * 5376 + oc) = v;
            }
          }
      }
    __syncthreads();
    {
      const int tid = tid_opq(); const int cg8 = (tid & 15) * 8, rbase = tid >> 4;
      const float* cw = conv_w + (size_t)l * 3 * 5376;
      const float* cb = conv_b + (size_t)l * 5376;
      float wa[3][8], wg[3][8], ba[8], bg[8];
#pragma unroll
      for (int i = 0; i < 3; ++i) {
        const f32x4 a0 = *(const f32x4*)(cw + i * 5376 + chb + cg8), a1 = *(const f32x4*)(cw + i * 5376 + chb + cg8 + 4);
        const f32x4 g0 = *(const f32x4*)(cw + i * 5376 + 2688 + chb + cg8), g1 = *(const f32x4*)(cw + i * 5376 + 2688 + chb + cg8 + 4);
        wa[i][0] = a0.x; wa[i][1] = a0.y; wa[i][2] = a0.z; wa[i][3] = a0.w; wa[i][4] = a1.x; wa[i][5] = a1.y; wa[i][6] = a1.z; wa[i][7] = a1.w;
        wg[i][0] = g0.x; wg[i][1] = g0.y; wg[i][2] = g0.z; wg[i][3] = g0.w; wg[i][4] = g1.x; wg[i][5] = g1.y; wg[i][6] = g1.z; wg[i][7] = g1.w;
      }
      {
        const f32x4 a0 = *(const f32x4*)(cb + chb + cg8), a1 = *(const f32x4*)(cb + chb + cg8 + 4);
        const f32x4 g0 = *(const f32x4*)(cb + 2688 + chb + cg8), g1 = *(const f32x4*)(cb + 2688 + chb + cg8 + 4);
        ba[0] = a0.x; ba[1] = a0.y; ba[2] = a0.z; ba[3] = a0.w; ba[4] = a1.x; ba[5] = a1.y; ba[6] = a1.z; ba[7] = a1.w;
        bg[0] = g0.x; bg[1] = g0.y; bg[2] = g0.z; bg[3] = g0.w; bg[4] = g1.x; bg[5] = g1.y; bg[6] = g1.z; bg[7] = g1.w;
      }
#pragma unroll 1
      for (int i = 0; i < 8; ++i) {
        const int R = rbase + 32 * i;
        if (R < 2) continue;
        u32x4 av[3], gv[3];
#pragma unroll
        for (int d = 0; d < 3; ++d) { av[d] = *(const u32x4*)(S + (R - 2 + d) * 264 + cg8); gv[d] = *(const u32x4*)(S + (R - 2 + d) * 264 + 128 + cg8); }
        float res[8];
#pragma unroll
        for (int e = 0; e < 8; ++e) {
          float ca = ba[e], cgv = bg[e];
#pragma unroll
          for (int d = 0; d < 3; ++d) {
            const unsigned aw = av[d][e >> 1], gw = gv[d][e >> 1];
            const float af = (e & 1) ? bfhi(aw) : bflo(aw), gf = (e & 1) ? bfhi(gw) : bflo(gw);
            ca += wa[d][e] * af; cgv += wg[d][e] * gf;
          }
          res[e] = ca * cgv / (1.f + __expf(-cgv));
        }
        u32x4 o; o.x = pk2(res[0], res[1]); o.y = pk2(res[2], res[3]); o.z = pk2(res[4], res[5]); o.w = pk2(res[6], res[7]);
        *(u32x4*)(act + (size_t)(pm * 256 + R) * 2688 + chb + cg8) = o;
      }
    }
    __syncthreads();
  }
};

DI float conv_act(float a0, float a1, float a2, float g0, float g1, float g2, const float* cw, const float* cb, int ch) {
  const float ca = cb[ch] + cw[ch] * a0 + cw[5376 + ch] * a1 + cw[2 * 5376 + ch] * a2;
  const float cgv = cb[2688 + ch] + cw[2688 + ch] * g0 + cw[5376 + 2688 + ch] * g1 + cw[2 * 5376 + 2688 + ch] * g2;
  return ca * cgv / (1.f + __expf(-cgv));
}
DI void fixup_phase(CParams& P, int l) {
  const float* halo = (const float*)(P.ws + WS_HALO);
  const float* ups = (const float*)(P.ws + WS_UPS);
  bf16_t* act = (bf16_t*)(P.ws + WS_ACT);
  const float* cw = P.in[25] + (size_t)l * 3 * 5376;
  const float* cb = P.in[26] + (size_t)l * 5376;
  const float* sconv = P.in[6] + (size_t)l * 128 * 2 * 5376;
  const int gt = blockIdx.x * 512 + tid_opq(), nthr = gridDim.x * 512;
  for (int idx = gt; idx < 128 * 2 * 2688; idx += nthr) {
    const int ch = idx % 2688, i = (idx / 2688) & 1, pm = idx / (2 * 2688);
    const bool first = (pm & 15) == 0;
    const float* cur = halo + (size_t)(pm * 4 + i) * 5376;
    const float* p1 = i == 1 ? halo + (size_t)(pm * 4 + 0) * 5376 : halo + (size_t)((pm - 1) * 4 + 3) * 5376;
    const float* p2 = i == 1 ? halo + (size_t)((pm - 1) * 4 + 3) * 5376 : halo + (size_t)((pm - 1) * 4 + 2) * 5376;
    const bool v1 = (i == 1) || !first, v2 = !first;
    const float a2 = cur[ch], g2 = cur[2688 + ch];
    const float a1 = v1 ? p1[ch] : 0.f, g1 = v1 ? p1[2688 + ch] : 0.f;
    const float a0 = v2 ? p2[ch] : 0.f, g0 = v2 ? p2[2688 + ch] : 0.f;
    const float r = conv_act(a0, a1, a2, g0, g1, g2, cw, cb, ch);
    act[(size_t)(pm * 256 + i) * 2688 + ch] = (bf16_t)(pk2(r, 0.f) & 0xffffu);
  }
  for (int idx = gt; idx < 512 * 2688; idx += nthr) {
    const int ch = idx % 2688, rs = idx / 2688, b = rs >> 2, t = rs & 3;
    const float* cur = ups + (size_t)rs * 5376;
    const float* sc = sconv + (size_t)b * 2 * 5376;
    const float* p1 = t >= 1 ? cur - 5376 : sc + 5376;
    const float* p2 = t >= 2 ? cur - 2 * 5376 : sc + (size_t)t * 5376;
    const float a2 = cur[ch], g2 = cur[2688 + ch];
    const float r = conv_act(p2[ch], p1[ch], a2, p2[2688 + ch], p1[2688 + ch], g2, cw, cb, ch);
    act[(size_t)(MP + rs) * 2688 + ch] = (bf16_t)(pk2(r, 0.f) & 0xffffu);
    if (t >= 2) {
      float* o = P.out + O_CS + ((size_t)((l * 128 + b) * 2 + (t - 2))) * 5376;
      o[ch] = a2; o[2688 + ch] = g2;
    }
  }
}

DI void attn_prompt_unit(CParams& P, int l, int unit, char* shm) {
  const int tid = tid_opq(); const int wid = tid >> 6, lane = tid & 63, fr = lane & 15, fq = lane >> 4;
  const int kvh = unit & 1, qb = (unit >> 1) & 31, b = unit >> 6;
  const bf16_t* qkv = (const bf16_t*)(P.ws + WS_QKV);
  bf16_t* attn = (bf16_t*)(P.ws + WS_ATT);
  bf16_t* Ks = (bf16_t*)shm;
  bf16_t* Vt = (bf16_t*)(shm + 36864);
#pragma unroll
  for (int p = 0; p < 4; ++p) {
    const int key = p * 64 + (tid >> 3), seg = tid & 7, kpos = qb * 128 - 128 + key;
    u32x4 v = (u32x4){0u, 0u, 0u, 0u};
    if (kpos >= 0) v = *(const u32x4*)(qkv + (size_t)(b * 4096 + kpos) * 768 + 512 + kvh * 64 + seg * 8);
    *(u32x4*)(Ks + key * 72 + seg * 8) = v;
  }
#pragma unroll
  for (int p = 0; p < 4; ++p) {
    const int key = p * 64 + (tid & 63), seg = tid >> 6, kpos = qb * 128 - 128 + key;
    u32x4 v = (u32x4){0u, 0u, 0u, 0u};
    if (kpos >= 0) v = *(const u32x4*)(qkv + (size_t)(b * 4096 + kpos) * 768 + 640 + kvh * 64 + seg * 8);
#pragma unroll
    for (int e = 0; e < 4; ++e) {
      Vt[(seg * 8 + 2 * e) * 264 + key] = (bf16_t)(v[e] & 0xffffu);
      Vt[(seg * 8 + 2 * e + 1) * 264 + key] = (bf16_t)(v[e] >> 16);
    }
  }
  __syncthreads();
  const int hh = wid >> 1, half = wid & 1, head = kvh * 4 + hh, q0l = half * 64;
  const float slope2 = exp2f(-(float)(head + 1)) * LOG2E;
  const float sink2 = P.in[9][l * 8 + head] * LOG2E;
  const float scale2 = 0.125f * LOG2E;
  bf16x8 qf[4][2];
#pragma unroll
  for (int qt = 0; qt < 4; ++qt)
#pragma unroll
    for (int kk = 0; kk < 2; ++kk)
      qf[qt][kk] = *(const bf16x8*)(qkv + (size_t)(b * 4096 + qb * 128 + q0l + qt * 16 + fr) * 768 + head * 64 + kk * 32 + fq * 8);
  float mrow[4], lsum[4];
  f32x4 o[4][4];
#pragma unroll
  for (int qt = 0; qt < 4; ++qt) {
    mrow[qt] = sink2; lsum[qt] = fq == 0 ? 1.f : 0.f;
#pragma unroll
    for (int dt = 0; dt < 4; ++dt) o[dt][qt] = (f32x4){0.f, 0.f, 0.f, 0.f};
  }
  for (int kt = 0; kt < 3; ++kt) {
    const int klb = q0l + kt * 64;
    f32x4 s[4][4];
#pragma unroll
    for (int ks = 0; ks < 4; ++ks) {
      const bf16x8 kf0 = *(const bf16x8*)(Ks + (klb + ks * 16 + fr) * 72 + fq * 8);
      const bf16x8 kf1 = *(const bf16x8*)(Ks + (klb + ks * 16 + fr) * 72 + 32 + fq * 8);
#pragma unroll
      for (int qt = 0; qt < 4; ++qt) {
        f32x4 z = (f32x4){0.f, 0.f, 0.f, 0.f};
        z = MFMA16(kf0, qf[qt][0], z);
        s[ks][qt] = MFMA16(kf1, qf[qt][1], z);
      }
    }
    bf16x8 pf[4][2];
#pragma unroll
    for (int qt = 0; qt < 4; ++qt) {
      const int qloc = q0l + qt * 16 + fr;
      float mx = -3.0e38f;
#pragma unroll
      for (int ks = 0; ks < 4; ++ks)
#pragma unroll
        for (int j = 0; j < 4; ++j) {
          const int kl = klb + ks * 16 + fq * 4 + j;
          const int dist = qloc + 128 - kl;
          const bool valid = dist >= 0 && dist < 128 && (qb > 0 || kl >= 128);
          const float val = valid ? s[ks][qt][j] * scale2 - slope2 * (float)dist : -1.0e30f;
          s[ks][qt][j] = val;
          mx = fmaxf(mx, val);
        }
      mx = fmaxf(mx, shx(mx, 16, lane));
      mx = fmaxf(mx, shx(mx, 32, lane));
      const float mnew = fmaxf(mrow[qt], mx);
      const float alpha = exp2f(mrow[qt] - mnew);
      mrow[qt] = mnew;
      float psum = 0.f;
#pragma unroll
      for (int ks = 0; ks < 4; ++ks)
#pragma unroll
        for (int j = 0; j < 4; ++j) { const float pv = exp2f(s[ks][qt][j] - mnew); s[ks][qt][j] = pv; psum += pv; }
      lsum[qt] = lsum[qt] * alpha + psum;
#pragma unroll
      for (int dt = 0; dt < 4; ++dt) o[dt][qt] = o[dt][qt] * alpha;
#pragma unroll
      for (int ksp = 0; ksp < 2; ++ksp) {
        u32x4 pw;
        pw.x = pk2(s[2 * ksp][qt][0], s[2 * ksp][qt][1]); pw.y = pk2(s[2 * ksp][qt][2], s[2 * ksp][qt][3]);
        pw.z = pk2(s[2 * ksp + 1][qt][0], s[2 * ksp + 1][qt][1]); pw.w = pk2(s[2 * ksp + 1][qt][2], s[2 * ksp + 1][qt][3]);
        pf[qt][ksp] = as_bf16x8(pw);
      }
    }
#pragma unroll
    for (int ksp = 0; ksp < 2; ++ksp)
#pragma unroll
      for (int dt = 0; dt < 4; ++dt) {
        const u32x2 v0 = *(const u32x2*)(Vt + (dt * 16 + fr) * 264 + klb + (2 * ksp) * 16 + fq * 4);
        const u32x2 v1 = *(const u32x2*)(Vt + (dt * 16 + fr) * 264 + klb + (2 * ksp + 1) * 16 + fq * 4);
        const bf16x8 vf = as_bf16x8((u32x4){v0.x, v0.y, v1.x, v1.y});
#pragma unroll
        for (int qt = 0; qt < 4; ++qt) o[dt][qt] = MFMA16(vf, pf[qt][ksp], o[dt][qt]);
      }
  }
#pragma unroll
  for (int qt = 0; qt < 4; ++qt) {
    float lt = lsum[qt];
    lt += shx(lt, 16, lane); lt += shx(lt, 32, lane);
    const float inv = 1.f / lt;
    const size_t row = (size_t)(b * 4096 + qb * 128 + q0l + qt * 16 + fr);
#pragma unroll
    for (int dt = 0; dt < 4; ++dt) {
      const f32x4 v = o[dt][qt] * inv;
      u32x2 ov; ov.x = pk2(v.x, v.y); ov.y = pk2(v.z, v.w);
      *(u32x2*)(attn + row * 512 + head * 64 + dt * 16 + fq * 4) = ov;
    }
  }
  __syncthreads();
}

DI void attn_sample_unit(CParams& P, int l, int unit, char* shm) {
  const int tid = tid_opq();
  const int kvh = unit & 1, b = unit >> 1;
  const bf16_t* qkv = (const bf16_t*)(P.ws + WS_QKV);
  bf16_t* attn = (bf16_t*)(P.ws + WS_ATT);
  float* Ksf = (float*)shm;
  float* Vsf = Ksf + 132 * 65;
  float* Qsf = Vsf + 132 * 65;
  float* Ps = Qsf + 16 * 64;
  const float* ck = P.in[2] + (size_t)(l * 128 + b) * 128 * 128;
  const float* cv = P.in[3] + (size_t)(l * 128 + b) * 128 * 128;
  float* okw = P.out + O_KS + (size_t)(l * 128 + b) * 128 * 128;
  float* ovw = P.out + O_VS + (size_t)(l * 128 + b) * 128 * 128;
#pragma unroll 4
  for (int i = 0; i < 16; ++i) {
    const int idx = tid + 512 * i, key = idx >> 6, d = idx & 63;
    const float kv = ck[key * 128 + kvh * 64 + d], vv = cv[key * 128 + kvh * 64 + d];
    Ksf[key * 65 + d] = kv; Vsf[key * 65 + d] = vv;
    if (key >= 4) { okw[(key - 4) * 128 + kvh * 64 + d] = kv; ovw[(key - 4) * 128 + kvh * 64 + d] = vv; }
  }
  if (tid < 256) {
    const int t = tid >> 6, d = tid & 63; const size_t row = (size_t)(MP + b * 4 + t);
    Ksf[(128 + t) * 65 + d] = bf2f(qkv[row * 768 + 512 + kvh * 64 + d]);
    Vsf[(128 + t) * 65 + d] = bf2f(qkv[row * 768 + 640 + kvh * 64 + d]);
  }
#pragma unroll
  for (int i = 0; i < 2; ++i) {
    const int idx = tid + 512 * i, rq = idx >> 6, d = idx & 63, hh = rq >> 2, t = rq & 3;
    Qsf[rq * 64 + d] = bf2f(qkv[(size_t)(MP + b * 4 + t) * 768 + (kvh * 4 + hh) * 64 + d]);
  }
  __syncthreads();
  const int rq = tid >> 5, kl = tid & 31, hh = rq >> 2, t = rq & 3, head = kvh * 4 + hh;
  {
    const float slope = exp2f(-(float)(head + 1));
    const float sink = P.in[9][l * 8 + head];
    float sc[5]; float mx = sink;
#pragma unroll
    for (int i = 0; i < 5; ++i) {
      const int key = kl + 32 * i;
      float val = -1.0e30f;
      if (key < 132) {
        float dot = 0.f;
#pragma unroll 8
        for (int d = 0; d < 64; ++d) dot += Qsf[rq * 64 + d] * Ksf[key * 65 + d];
        const int dist = key < 128 ? (t + 128 - key) : (t - (key - 128));
        if (dist >= 0 && dist < 128) val = dot * 0.125f - slope * (float)dist;
      }
      sc[i] = val; mx = fmaxf(mx, val);
    }
#pragma unroll
    for (int o = 1; o < 32; o <<= 1) mx = fmaxf(mx, shx(mx, o, tid & 63));
    float sum = 0.f;
#pragma unroll
    for (int i = 0; i < 5; ++i) { sc[i] = __expf(sc[i] - mx); sum += sc[i]; }
#pragma unroll
    for (int o = 1; o < 32; o <<= 1) sum += shx(sum, o, tid & 63);
    sum += __expf(sink - mx);
    const float inv = 1.f / sum;
#pragma unroll
    for (int i = 0; i < 5; ++i) { const int key = kl + 32 * i; if (key < 132) Ps[rq * 136 + key] = sc[i] * inv; }
  }
  __syncthreads();
  {
    float a0 = 0.f, a1 = 0.f;
#pragma unroll 4
    for (int key = 0; key < 132; ++key) { const float p = Ps[rq * 136 + key]; a0 += p * Vsf[key * 65 + kl]; a1 += p * Vsf[key * 65 + kl + 32]; }
    const size_t row = (size_t)(MP + b * 4 + t);
    attn[row * 512 + head * 64 + kl] = (bf16_t)(pk2(a0, 0.f) & 0xffffu);
    attn[row * 512 + head * 64 + kl + 32] = (bf16_t)(pk2(a1, 0.f) & 0xffffu);
  }
  __syncthreads();
}

DI void sincos_rev(double ang, float& s, float& c) {
  double r = ang * 0.15915494309189535;
  r -= __builtin_rint(r);
  const float x = (float)(r * 6.283185307179586);
  s = sinf(x); c = cosf(x);
}
DI void s5_item(CParams& P, int l, int mode, int item, char* wl, int lane) {
  int b, c, g;
  g = item & 31;
  if (mode == 2) { b = item >> 5; c = 0; } else { c = (item >> 5) & 7; b = item >> 8; }
  const int n = lane, fr = lane & 15, fq = lane >> 4;
  const int gi = (l * 32 + g) * 64 + n;
  const float lr = P.in[10][gi], li = P.in[11][gi];
  const float dt = expf(P.in[12][l * 32 + g]);
  float lbr, lbi;
  {
    const float mag = expf(lr * dt); float sn, cs; sincos_rev((double)li * (double)dt, sn, cs);
    lbr = mag * cs; lbi = mag * sn;
  }
  float bbr[16], bbi[16];
  {
    const float den = 1.f / (lr * lr + li * li);
    const float e1 = lbr - 1.f;
    const float qr = (e1 * lr + lbi * li) * den, qi = (lbi * lr - e1 * li) * den;
    const float* br = P.in[13] + (size_t)gi * 16; const float* bi = P.in[14] + (size_t)gi * 16;
#pragma unroll
    for (int q = 0; q < 4; ++q) {
      const f32x4 r4 = *(const f32x4*)(br + 4 * q), i4 = *(const f32x4*)(bi + 4 * q);
#pragma unroll
      for (int e = 0; e < 4; ++e) { bbr[4 * q + e] = qr * r4[e] - qi * i4[e]; bbi[4 * q + e] = qr * i4[e] + qi * r4[e]; }
    }
  }
  float sr = 0.f, si = 0.f;
  float* ends = (float*)(P.ws + WS_ENDS);
  if (mode == 2) { const size_t o = ((size_t)(l * 128 + b) * 32 + g) * 64 + n; sr = P.in[4][o]; si = P.in[5][o]; }
  else if (mode == 1 && c > 0) {
    float pr, pi;
    { const float mag = expf(lr * dt * 512.f); float sn, cs; sincos_rev((double)li * (double)dt * 512.0, sn, cs); pr = mag * cs; pi = mag * sn; }
    for (int c2 = 0; c2 < c; ++c2) {
      const float* e = ends + ((size_t)((b * 8 + c2) * 32 + g) * 64 + n) * 2;
      const float er = e[0], ei = e[1];
      const float nr = pr * sr - pi * si + er, ni = pr * si + pi * sr + ei;
      sr = nr; si = ni;
    }
  }
  const int ntok = mode == 2 ? 4 : 512;
  const size_t row0 = mode == 2 ? (size_t)(MP + b * 4) : (size_t)(b * 4096 + c * 512);
  const float* U = (const float*)(P.ws + WS_U);
  bf16_t* ssr = (bf16_t*)(P.ws + WS_SSR);
  float* ul = (float*)wl;
  unsigned* Sl = (unsigned*)(wl + 2048);
  bf16x8 cfrag[4]; f32x4 dsk = (f32x4){0.f, 0.f, 0.f, 0.f};
  if (mode >= 1) {
#pragma unroll
    for (int kk = 0; kk < 4; ++kk) {
      const size_t o = ((size_t)(l * 32 + g) * 16 + fr) * 64 + kk * 16 + fq * 4;
      const f32x4 cr = *(const f32x4*)(P.in[15] + o), ci = *(const f32x4*)(P.in[16] + o);
      u32x4 w; w.x = pk2(cr.x, -ci.x); w.y = pk2(cr.y, -ci.y); w.z = pk2(cr.z, -ci.z); w.w = pk2(cr.w, -ci.w);
      cfrag[kk] = as_bf16x8(w);
    }
    dsk = *(const f32x4*)(P.in[17] + l * 512 + g * 16 + fq * 4);
  } else {
#pragma unroll
    for (int kk = 0; kk < 4; ++kk) cfrag[kk] = as_bf16x8((u32x4){0u, 0u, 0u, 0u});
  }
  const int nsub = (ntok + 15) >> 4;
  f32x4 upre = (f32x4){0.f, 0.f, 0.f, 0.f};
  { const int tok = lane >> 2, seg = lane & 3; if (tok < ntok) upre = *(const f32x4*)(U + (row0 + tok) * 512 + g * 16 + seg * 4); }
  for (int sub = 0; sub < nsub; ++sub) {
    float* uc = ul + (sub & 1) * 256;
    *(f32x4*)(uc + lane * 4) = upre;
    if (sub + 1 < nsub) { const int tok = (sub + 1) * 16 + (lane >> 2), seg = lane & 3; upre = *(const f32x4*)(U + (row0 + tok) * 512 + g * 16 + seg * 4); }
    const int tmax = ntok - sub * 16 < 16 ? ntok - sub * 16 : 16;
#pragma unroll 4
    for (int tt = 0; tt < 16; ++tt) {
      if (tt < tmax) {
        const f32x4 u0 = *(const f32x4*)(uc + tt * 16), u1 = *(const f32x4*)(uc + tt * 16 + 4), u2 = *(const f32x4*)(uc + tt * 16 + 8), u3 = *(const f32x4*)(uc + tt * 16 + 12);
        float bur = 0.f, bui = 0.f;
#pragma unroll
        for (int e = 0; e < 4; ++e) {
          bur += u0[e] * bbr[e]; bui += u0[e] * bbi[e];
          bur += u1[e] * bbr[4 + e]; bui += u1[e] * bbi[4 + e];
          bur += u2[e] * bbr[8 + e]; bui += u2[e] * bbi[8 + e];
          bur += u3[e] * bbr[12 + e]; bui += u3[e] * bbi[12 + e];
        }
        const float nr = lbr * sr - lbi * si + bur, ni = lbr * si + lbi * sr + bui;
        sr = nr; si = ni;
        if (mode >= 1) Sl[tt * 68 + n] = pk2(sr, si);
      }
    }
    if (mode >= 1) {
      f32x4 acc = (f32x4){0.f, 0.f, 0.f, 0.f};
#pragma unroll
      for (int kk = 0; kk < 4; ++kk) {
        const u32x4 sv = *(const u32x4*)(Sl + fr * 68 + kk * 16 + fq * 4);
        acc = MFMA16(cfrag[kk], as_bf16x8(sv), acc);
      }
      if (fr < tmax) {
        const f32x4 u4 = *(const f32x4*)(uc + fr * 16 + fq * 4);
        float y[4];
#pragma unroll
        for (int j = 0; j < 4; ++j) {
          const float x = acc[j] + dsk[j] * u4[j];
          const float z2 = 1.5957691216057308f * (x + 0.044715f * x * x * x);
          y[j] = x / (1.f + __expf(-z2));
        }
        u32x2 ov; ov.x = pk2(y[0], y[1]); ov.y = pk2(y[2], y[3]);
        *(u32x2*)(ssr + (row0 + sub * 16 + fr) * 512 + g * 16 + fq * 4) = ov;
      }
    }
  }
  if (mode == 0) { float* e = ends + ((size_t)((b * 8 + c) * 32 + g) * 64 + n) * 2; e[0] = sr; e[1] = si; }
  else if (mode == 1) { if (c == 7) { const size_t o = ((size_t)(l * 8 + b) * 32 + g) * 64 + n; P.out[O_RP + o] = sr; P.out[O_IP + o] = si; } }
  else { const size_t o = ((size_t)(l * 128 + b) * 32 + g) * 64 + n; P.out[O_RS + o] = sr; P.out[O_IS + o] = si; }
}

DI void merge_phase(CParams& P, int l) {
  const int tid = tid_opq(); const int wid = tid >> 6, lane = tid & 63;
  const bf16_t* attn = (const bf16_t*)(P.ws + WS_ATT);
  const bf16_t* ss2 = (const bf16_t*)(P.ws + WS_SS2);
  bf16_t* h = (bf16_t*)(P.ws + WS_H);
  const float* ga = P.in[20] + l * 512 + lane * 8;
  const float* gs = P.in[21] + l * 512 + lane * 8;
  const f32x4 ga0 = *(const f32x4*)ga, ga1 = *(const f32x4*)(ga + 4), gs0 = *(const f32x4*)gs, gs1 = *(const f32x4*)(gs + 4);
  for (int r = blockIdx.x * 8 + wid; r < MT; r += gridDim.x * 8) {
    const u32x4 av = *(const u32x4*)(attn + (size_t)r * 512 + lane * 8);
    const u32x4 sv = *(const u32x4*)(ss2 + (size_t)r * 512 + lane * 8);
    float a[8], s[8]; float qa = 0.f, qs = 0.f;
#pragma unroll
    for (int e = 0; e < 4; ++e) { a[2 * e] = bflo(av[e]); a[2 * e + 1] = bfhi(av[e]); s[2 * e] = bflo(sv[e]); s[2 * e + 1] = bfhi(sv[e]); }
#pragma unroll
    for (int e = 0; e < 8; ++e) { qa += a[e] * a[e]; qs += s[e] * s[e]; }
    qa = wave_sum(qa, lane); qs = wave_sum(qs, lane);
    const float ra = rsqrtf(qa * (1.f / 512.f) + EPS), rs = rsqrtf(qs * (1.f / 512.f) + EPS);
    u32x4 oa, os;
    oa.x = pk2(a[0] * ra * ga0.x, a[1] * ra * ga0.y); oa.y = pk2(a[2] * ra * ga0.z, a[3] * ra * ga0.w);
    oa.z = pk2(a[4] * ra * ga1.x, a[5] * ra * ga1.y); oa.w = pk2(a[6] * ra * ga1.z, a[7] * ra * ga1.w);
    os.x = pk2(s[0] * rs * gs0.x, s[1] * rs * gs0.y); os.y = pk2(s[2] * rs * gs0.z, s[3] * rs * gs0.w);
    os.z = pk2(s[4] * rs * gs1.x, s[5] * rs * gs1.y); os.w = pk2(s[6] * rs * gs1.z, s[7] * rs * gs1.w);
    *(u32x4*)(h + (size_t)r * 1024 + lane * 8) = oa;
    *(u32x4*)(h + (size_t)r * 1024 + 512 + lane * 8) = os;
  }
}

#ifndef SKIP_MASK
#define SKIP_MASK 0
#endif
#define PH(x) if constexpr (!((SKIP_MASK >> (x)) & 1))
#ifndef GEMMFN
#define GEMMFN gemm_phase8
#endif
template <int l>
DI void layer_body(CParams* kp, char* shm, cg::grid_group& grid) {
#define P (*launder(kp))
  const int nblk = gridDim.x;
  bf16_t* wt0 = (bf16_t*)(P.ws + WS_WT);
  bf16_t* hbuf = (bf16_t*)(P.ws + WS_H);
  float* xcur = (float*)(P.ws + WS_X);

    const bf16_t* wt = wt0 + (size_t)l * WT_LAYER;
    PH(1) {
      EpiIn e; e.l = l; e.qkv = (bf16_t*)(P.ws + WS_QKV); e.u = (float*)(P.ws + WS_U); e.out = P.out;
      GEMMFN(hbuf, wt + WT_IN, 130, 5, 1024, e, shm);
    }
    grid.sync();
    {
      PH(2) for (int u = blockIdx.x; u < 512; u += nblk) attn_prompt_unit(P, l, u, shm);
      PH(3) for (int u = blockIdx.x; u < 256; u += nblk) attn_sample_unit(P, l, u, shm);
      const int tq = tid_opq(); const int wv = __builtin_amdgcn_readfirstlane(tq >> 6), lane = tq & 63;
      PH(4) for (int it = blockIdx.x * 8 + wv; it < 2048; it += nblk * 8) s5_item(P, l, 0, it, shm + wv * 6656, lane);
    }
    grid.sync();
    {
      const int tq = tid_opq(); const int wv = __builtin_amdgcn_readfirstlane(tq >> 6), lane = tq & 63;
      PH(5) for (int it = blockIdx.x * 8 + wv; it < 2048; it += nblk * 8) s5_item(P, l, 1, it, shm + wv * 6656, lane);
      PH(6) for (int it = blockIdx.x * 8 + wv; it < 4096; it += nblk * 8) s5_item(P, l, 2, it, shm + wv * 6656, lane);
    }
    grid.sync();
    PH(7) {
      EpiGlu e; e.ssr = (const bf16_t*)(P.ws + WS_SSR); e.ss2 = (bf16_t*)(P.ws + WS_SS2); e.bias = P.in[19] + l * 512;
      GEMMFN((const bf16_t*)(P.ws + WS_SSR), wt + WT_GLU, 130, 2, 512, e, shm);
    }
    grid.sync();
    PH(8) merge_phase(P, l);
    grid.sync();
    PH(9) {
      EpiRes e; e.xp = P.in[0]; e.xs = P.in[1]; e.xcur = xcur; e.from_in = (l == 0);
      GEMMFN(hbuf, wt + WT_OUT, 130, 4, 1024, e, shm);
    }
    grid.sync();
    PH(10) norm_phase(P, 1, P.in[23] + l * 1024);
    grid.sync();
    PH(11) {
      EpiUp e; e.l = l; e.act = (bf16_t*)(P.ws + WS_ACT); e.halo = (float*)(P.ws + WS_HALO); e.ups = (float*)(P.ws + WS_UPS);
      e.conv_w = P.in[25]; e.conv_b = P.in[26]; e.out = P.out;
      GEMMFN(hbuf, wt + WT_UP, 130, 21, 1024, e, shm);
    }
    grid.sync();
    PH(12) fixup_phase(P, l);
    grid.sync();
    PH(13) {
      EpiRes e; e.xp = P.in[0]; e.xs = P.in[1]; e.xcur = xcur; e.from_in = 0;
      GEMMFN((const bf16_t*)(P.ws + WS_ACT), wt + WT_DOWN, 130, 4, 2688, e, shm);
    }
    grid.sync();
    if (l == 0) { norm_phase(P, 1, P.in[7] + 1024); grid.sync(); }
    else final_norm_phase(P);
#undef P
}
__global__ void __launch_bounds__(512) mega(Params Parg) {
  extern __shared__ __attribute__((aligned(16))) char shm[];
  CParams* kp = (CParams*)__builtin_amdgcn_kernarg_segment_ptr();
  cg::grid_group grid = cg::this_grid();
  PH(0) phase0(*launder(kp), shm);
  grid.sync();
  layer_body<0>(kp, shm, grid);
  layer_body<1>(kp, shm, grid);
}
extern "C" void kernel_launch(void* const* d_in, const int* in_sizes, int n_in, void* d_out, int out_size, void* d_ws, size_t ws_size, hipStream_t stream) {
  static int grid_blocks = 0;
  if (grid_blocks == 0) {
    if (n_in != 29 || ws_size < WS_TOTAL) { fprintf(stderr, "kernel_launch: unexpected n_in %d or ws_size %zu (< %zu)\n", n_in, ws_size, (size_t)WS_TOTAL); grid_blocks = -1; return; }
    int dev = 0, cus = 0, per_cu = 0;
    hipGetDevice(&dev);
    hipDeviceGetAttribute(&cus, hipDeviceAttributeMultiprocessorCount, dev);
    hipFuncSetAttribute((const void*)mega, hipFuncAttributeMaxDynamicSharedMemorySize, LDS_BYTES);
    hipOccupancyMaxActiveBlocksPerMultiprocessor(&per_cu, (const void*)mega, 512, LDS_BYTES);
    if (per_cu < 1) per_cu = 1;
    if (per_cu > 1) per_cu = 1;
    grid_blocks = cus * per_cu;
  }
  if (grid_blocks < 0) return;
  Params p{};
  for (int i = 0; i < 29; ++i) p.in[i] = (const float*)d_in[i];
  p.out = (float*)d_out;
  p.ws = (char*)d_ws;
  void* args[] = {&p};
  hipError_t e = hipLaunchCooperativeKernel((const void*)mega, dim3(grid_blocks), dim3(512), args, LDS_BYTES, stream);
  if (e != hipSuccess) fprintf(stderr, "cooperative launch failed: %s (grid %d)\n", hipGetErrorString(e), grid_blocks);
}
```

```cpp
#include <hip/hip_runtime.h>
#include <hip/hip_cooperative_groups.h>
#include <cstdint>
#include <cstdio>
namespace cg = cooperative_groups;

#define DI __device__ __forceinline__
typedef unsigned short bf16_t;
typedef short bf16x8 __attribute__((ext_vector_type(8)));
typedef float f32x4 __attribute__((ext_vector_type(4)));
typedef unsigned u32x4 __attribute__((ext_vector_type(4)));
typedef unsigned u32x2 __attribute__((ext_vector_type(2)));

constexpr int MP = 32768, MT = 33280;
constexpr float EPS = 1e-5f;
constexpr float LOG2E = 1.4426950408889634f;

constexpr size_t O_Y = 0, O_KP = 34078720, O_VP = 34340864, O_RP = 34603008, O_IP = 34635776, O_CP = 34668544,
                 O_KS = 34840576, O_VS = 39034880, O_RS = 43229184, O_IS = 43753472, O_CS = 44277760;
constexpr size_t WS_WT = 0, WS_H = 43515904, WS_X = 111673344, WS_R = 247988224;
constexpr size_t WS_QKV = WS_R, WS_U = WS_R + 51118080, WS_ATT = WS_R + 119275520, WS_SSR = WS_R + 153354240, WS_SS2 = WS_R + 187432960;
constexpr size_t WS_ACT = WS_R;
constexpr size_t WS_HALO = 469499904, WS_UPS = 480509952, WS_ENDS = 491520000, WS_BAR = 492568576, WS_TOTAL = 492568576 + 16384;
constexpr size_t WT_IN = 0, WT_GLU = 1310720, WT_OUT = 1572864, WT_UP = 2621440, WT_DOWN = 8126464, WT_LAYER = 10878976;
constexpr int LDS_BYTES = 136 * 1024;

struct Params {
  const float* in[29];
  float* out;
  char* ws;
};

typedef const __attribute__((address_space(4))) Params CParams;
DI CParams* launder(CParams* p) { asm volatile("" : "+s"(p)); return p; }
DI unsigned pk2(float lo, float hi) { unsigned r; asm("v_cvt_pk_bf16_f32 %0, %1, %2" : "=v"(r) : "v"(lo), "v"(hi)); return r; }
DI float bflo(unsigned u) { return __uint_as_float(u << 16); }
DI float bfhi(unsigned u) { return __uint_as_float(u & 0xffff0000u); }
DI float bf2f(bf16_t b) { return __uint_as_float(((unsigned)b) << 16); }
DI float shx(float v, int o, int lane) { return __int_as_float(__builtin_amdgcn_ds_bpermute((lane ^ o) << 2, __float_as_int(v))); }
DI float wave_sum(float v, int lane) {
#pragma unroll
  for (int o = 1; o < 64; o <<= 1) v += shx(v, o, lane);
  return v;
}
DI int tid_opq() { int t = threadIdx.x; asm volatile("" : "+v"(t)); return t; }
DI bf16x8 as_bf16x8(u32x4 v) { return __builtin_bit_cast(bf16x8, v); }
#define MFMA16(a, b, c) __builtin_amdgcn_mfma_f32_16x16x32_bf16((a), (b), (c), 0, 0, 0)

DI void transpose_item(const float* __restrict__ W, int K, int N, bf16_t* __restrict__ WT, int item, float* scr, int tid, bool perm_up) {
  const int nblk = N / 64, kb = item / nblk, nb = item % nblk, k0 = kb * 64, n0 = nb * 64;
  int src_n0 = n0;
  if (perm_up) { const int tile = n0 >> 8, j = n0 & 255; src_n0 = (j < 128) ? tile * 128 + j : 2688 + tile * 128 + (j - 128); }
#pragma unroll
  for (int i = 0; i < 8; ++i) { const int kk = (tid >> 6) + 8 * i, nn = tid & 63; scr[kk * 65 + nn] = W[(size_t)(k0 + kk) * N + src_n0 + nn]; }
  __syncthreads();
  {
    const int nn = tid >> 3, c = tid & 7;
    const float* s = scr + (8 * c) * 65 + nn;
    u32x4 o;
    o.x = pk2(s[0 * 65], s[1 * 65]); o.y = pk2(s[2 * 65], s[3 * 65]); o.z = pk2(s[4 * 65], s[5 * 65]); o.w = pk2(s[6 * 65], s[7 * 65]);
    *(u32x4*)(WT + (size_t)(n0 + nn) * K + k0 + 8 * c) = o;
  }
  __syncthreads();
}

DI void norm_row_bf16(const float* __restrict__ xr, const float* __restrict__ g, bf16_t* __restrict__ orow, int lane) {
  f32x4 v[4]; float s = 0.f;
#pragma unroll
  for (int j = 0; j < 4; ++j) { v[j] = ((const f32x4*)xr)[lane + 64 * j]; s += v[j].x * v[j].x + v[j].y * v[j].y + v[j].z * v[j].z + v[j].w * v[j].w; }
  s = wave_sum(s, lane);
  const float rstd = rsqrtf(s * (1.f / 1024.f) + EPS);
#pragma unroll
  for (int j = 0; j < 4; ++j) {
    const f32x4 gg = ((const f32x4*)g)[lane + 64 * j];
    u32x2 o; o.x = pk2(v[j].x * rstd * gg.x, v[j].y * rstd * gg.y); o.y = pk2(v[j].z * rstd * gg.z, v[j].w * rstd * gg.w);
    ((u32x2*)orow)[lane + 64 * j] = o;
  }
}
DI void norm_row_f32(const float* __restrict__ xr, const float* __restrict__ g, float* __restrict__ orow, int lane) {
  f32x4 v[4]; float s = 0.f;
#pragma unroll
  for (int j = 0; j < 4; ++j) { v[j] = ((const f32x4*)xr)[lane + 64 * j]; s += v[j].x * v[j].x + v[j].y * v[j].y + v[j].z * v[j].z + v[j].w * v[j].w; }
  s = wave_sum(s, lane);
  const float rstd = rsqrtf(s * (1.f / 1024.f) + EPS);
#pragma unroll
  for (int j = 0; j < 4; ++j) {
    const f32x4 gg = ((const f32x4*)g)[lane + 64 * j];
    f32x4 o; o.x = v[j].x * rstd * gg.x; o.y = v[j].y * rstd * gg.y; o.z = v[j].z * rstd * gg.z; o.w = v[j].w * rstd * gg.w;
    ((f32x4*)orow)[lane + 64 * j] = o;
  }
}
DI const float* xrow_in(CParams& P, int r) { return r < MP ? P.in[0] + (size_t)r * 1024 : P.in[1] + (size_t)(r - MP) * 1024; }

DI void norm_phase(CParams& P, int mode, const float* g) {
  const int tid = tid_opq(); const int wid = tid >> 6, lane = tid & 63;
  const float* xcur = (const float*)(P.ws + WS_X);
  bf16_t* h = (bf16_t*)(P.ws + WS_H);
  for (int r = blockIdx.x * 8 + wid; r < MT; r += gridDim.x * 8) {
    const float* xr = mode == 0 ? xrow_in(P, r) : xcur + (size_t)r * 1024;
    norm_row_bf16(xr, g, h + (size_t)r * 1024, lane);
  }
}
DI void final_norm_phase(CParams& P) {
  const int tid = tid_opq(); const int wid = tid >> 6, lane = tid & 63;
  const float* xcur = (const float*)(P.ws + WS_X);
  for (int r = blockIdx.x * 8 + wid; r < MT; r += gridDim.x * 8)
    norm_row_f32(xcur + (size_t)r * 1024, P.in[28], P.out + O_Y + (size_t)r * 1024, lane);
}

DI void phase0(CParams& P, char* shm) {
  const int tid = tid_opq();
  constexpr int per_layer = 320 + 64 + 256 + 1344 + 672;
  bf16_t* wt0 = (bf16_t*)(P.ws + WS_WT);
  for (int it = blockIdx.x; it < 2 * per_layer; it += gridDim.x) {
    const int l = it / per_layer; int r = it % per_layer;
    bf16_t* wt = wt0 + (size_t)l * WT_LAYER;
    if (r < 320) { transpose_item(P.in[8] + (size_t)l * 1024 * 1280, 1024, 1280, wt + WT_IN, r, (float*)shm, tid, false); continue; }
    r -= 320;
    if (r < 64) { transpose_item(P.in[18] + (size_t)l * 512 * 512, 512, 512, wt + WT_GLU, r, (float*)shm, tid, false); continue; }
    r -= 64;
    if (r < 256) { transpose_item(P.in[22] + (size_t)l * 1024 * 1024, 1024, 1024, wt + WT_OUT, r, (float*)shm, tid, false); continue; }
    r -= 256;
    if (r < 1344) { transpose_item(P.in[24] + (size_t)l * 1024 * 5376, 1024, 5376, wt + WT_UP, r, (float*)shm, tid, true); continue; }
    r -= 1344;
    transpose_item(P.in[27] + (size_t)l * 2688 * 1024, 2688, 1024, wt + WT_DOWN, r, (float*)shm, tid, false);
  }
  norm_phase(P, 0, P.in[7]);
}

DI int lds_byte(int r, int c) { const int st = (r >> 4) * 2 + (c >> 5), rr = r & 15, cc = c & 31, ob = rr * 64 + cc * 2; return st * 1024 + (ob ^ (((ob >> 9) & 1) << 5)); }
DI void stage_rc(int b, int& R, int& C) { const int st = b / 1024, sb = b % 1024, swz = sb ^ (((sb >> 9) & 1) << 5); R = (st >> 1) * 16 + swz / 64; C = (st & 1) * 32 + (swz % 64) / 2; }
DI void gl_lds16(const void* g, void* l) {
  __builtin_amdgcn_global_load_lds((const __attribute__((address_space(1))) void*)g, (__attribute__((address_space(3))) void*)l, 16, 0, 0);
}

template <class Epi>
DI void gemm_phase(const bf16_t* __restrict__ A, const bf16_t* __restrict__ Bt, int nM, int nN, int K, const Epi& epi, char* shm) {
  const int tid = tid_opq(); const int wid = tid >> 6, lane = tid & 63, wr = wid >> 2, wc = wid & 3, fr = lane & 15, fq = lane >> 4;
  const int nt = K / 64, ntiles = nM * nN;
  int sr0, sc0, sr1, sc1; stage_rc(tid * 16, sr0, sc0); stage_rc(tid * 16 + 8192, sr1, sc1);
  const unsigned go0 = (unsigned)(sr0 * K + sc0) * 2u, go1 = (unsigned)(sr1 * K + sc1) * 2u;
  const unsigned goh = (unsigned)(128 * K) * 2u;
  const int lob = fr * 64 + fq * 16;
  const int lswz = lob ^ (((lob >> 9) & 1) << 5);
  char* const a_base = shm + lswz + wr * 8192;
  char* const b_base = shm + 65536 + lswz + wc * 4096;
  char* const st_base = shm + tid * 16;
  for (int tile = blockIdx.x; tile < ntiles; tile += gridDim.x) {
    const int pm = tile / nN, pn = tile % nN;
    const char* Ab = (const char*)(A + (size_t)pm * 256 * K);
    const char* Bb = (const char*)(Bt + (size_t)pn * 256 * K);
    f32x4 acc[2][2][4][2];
#pragma unroll
    for (int a = 0; a < 2; ++a)
#pragma unroll
      for (int b = 0; b < 2; ++b)
#pragma unroll
        for (int m = 0; m < 4; ++m)
#pragma unroll
          for (int n = 0; n < 2; ++n) acc[a][b][m][n] = (f32x4){0.f, 0.f, 0.f, 0.f};

#define GEMM_STAGE(buf, kt)                                                         \
  do {                                                                              \
    const char* ak_ = Ab + (size_t)(kt) * 128;                                      \
    const char* bk_ = Bb + (size_t)(kt) * 128;                                      \
    char* la_ = st_base + (buf) * 32768;                                            \
    gl_lds16(ak_ + go0, la_);                                                       \
    gl_lds16(ak_ + go1, la_ + 8192);                                                \
    gl_lds16(ak_ + goh + go0, la_ + 16384);                                         \
    gl_lds16(ak_ + goh + go1, la_ + 16384 + 8192);                                  \
    gl_lds16(bk_ + go0, la_ + 65536);                                               \
    gl_lds16(bk_ + go1, la_ + 65536 + 8192);                                        \
    gl_lds16(bk_ + goh + go0, la_ + 65536 + 16384);                                 \
    gl_lds16(bk_ + goh + go1, la_ + 65536 + 16384 + 8192);                          \
  } while (0)

    GEMM_STAGE(0, 0);
    asm volatile("s_waitcnt vmcnt(0)" ::: "memory");
    __syncthreads();
    for (int t = 0; t < nt; ++t) {
      const int cur = t & 1;
      if (t + 1 < nt) GEMM_STAGE(cur ^ 1, t + 1);
      const char* ac = a_base + cur * 32768;
      const char* bc = b_base + cur * 32768;
      bf16x8 Bf[2][2][2];
#pragma unroll
      for (int bj = 0; bj < 2; ++bj)
#pragma unroll
        for (int n = 0; n < 2; ++n)
#pragma unroll
          for (int k = 0; k < 2; ++k) Bf[bj][n][k] = *(const bf16x8*)(bc + bj * 16384 + n * 2048 + k * 1024);
#pragma unroll
      for (int ai = 0; ai < 2; ++ai) {
        bf16x8 At[4][2];
        if (ai == 1) __builtin_amdgcn_sched_barrier(0);
#pragma unroll
        for (int m = 0; m < 4; ++m)
#pragma unroll
          for (int k = 0; k < 2; ++k) At[m][k] = *(const bf16x8*)(ac + ai * 16384 + m * 2048 + k * 1024);
#pragma unroll
        for (int bj = 0; bj < 2; ++bj)
#pragma unroll
          for (int m = 0; m < 4; ++m)
#pragma unroll
            for (int n = 0; n < 2; ++n)
#pragma unroll
              for (int k = 0; k < 2; ++k) acc[ai][bj][m][n] = MFMA16(Bf[bj][n][k], At[m][k], acc[ai][bj][m][n]);
      }
      asm volatile("s_waitcnt vmcnt(0)" ::: "memory");
      __syncthreads();
    }
    {
      int wr_ = wr, wc_ = wc, fr_ = fr, fq_ = fq;
      asm volatile("" : "+v"(wr_), "+v"(wc_), "+v"(fr_), "+v"(fq_));
      epi(acc, pm, pn, wr_, wc_, fr_, fq_, shm);
    }
  }
}

template <class Epi>
DI void gemm_phase8(const bf16_t* __restrict__ A, const bf16_t* __restrict__ Bt, int nM, int nN, int K, const Epi& epi, char* shm) {
  const int tid = tid_opq(); const int wid = tid >> 6, lane = tid & 63, wr = wid >> 2, wc = wid & 3, fr = lane & 15, fq = lane >> 4;
  const int nt = K / 64, ntiles = nM * nN;
  int sr0, sc0, sr1, sc1; stage_rc(tid * 16, sr0, sc0); stage_rc(tid * 16 + 8192, sr1, sc1);
  const unsigned go0 = (unsigned)(sr0 * K + sc0) * 2u, go1 = (unsigned)(sr1 * K + sc1) * 2u;
  const unsigned goh = (unsigned)(128 * K) * 2u;
  const int lob = fr * 64 + fq * 16;
  const int lswz = lob ^ (((lob >> 9) & 1) << 5);
  char* const a_base = shm + lswz + wr * 8192;
  char* const b_base = shm + 65536 + lswz + wc * 4096;
  const int wave_s = __builtin_amdgcn_readfirstlane(wid);
  char* const st_base = shm + wave_s * 1024;
#define SA8(b, h) (((b) * 2 + (h)) * 16384)
#define SB8(b, h) ((4 + (b) * 2 + (h)) * 16384)
#define STG8(ldsoff, panel, kt) do { const char* g_ = (panel) + (size_t)(kt) * 128; asm volatile("" : "+s"(g_)); gl_lds16(g_ + go0, st_base + (ldsoff)); gl_lds16(g_ + go1, st_base + (ldsoff) + 8192); } while (0)
#define LDA8(dst, b, h) _Pragma("unroll") for (int m = 0; m < 4; ++m) _Pragma("unroll") for (int k = 0; k < 2; ++k) dst[m][k] = *(const bf16x8*)(a_base + SA8(b, h) + m * 2048 + k * 1024)
#define LDB8(dst, b, h) _Pragma("unroll") for (int n = 0; n < 2; ++n) _Pragma("unroll") for (int k = 0; k < 2; ++k) dst[n][k] = *(const bf16x8*)(b_base + ((b) * 2 + (h)) * 16384 + n * 2048 + k * 1024)
#define MMA8(ai, bj, Ax, Bx) do { __builtin_amdgcn_s_setprio(1); \
    _Pragma("unroll") for (int m = 0; m < 4; ++m) _Pragma("unroll") for (int n = 0; n < 2; ++n) _Pragma("unroll") for (int k = 0; k < 2; ++k) \
      acc[ai][bj][m][n] = MFMA16(Bx[n][k], Ax[m][k], acc[ai][bj][m][n]); \
    __builtin_amdgcn_s_setprio(0); } while (0)
#define WAIT_V(n) asm volatile("s_waitcnt vmcnt(" #n ")" ::: "memory")
#define WAIT_L(n) asm volatile("s_waitcnt lgkmcnt(" #n ")" ::: "memory")
#define BAR8 __builtin_amdgcn_s_barrier()
#define SCHED8 __builtin_amdgcn_sched_barrier(0)
  for (int tile = blockIdx.x; tile < ntiles; tile += gridDim.x) {
    const int pm = tile / nN, pn = tile % nN;
    const char* A0 = (const char*)(A + (size_t)pm * 256 * K);
    const char* A1 = A0 + goh;
    const char* B0p = (const char*)(Bt + (size_t)pn * 256 * K);
    const char* B1p = B0p + goh;
    f32x4 acc[2][2][4][2];
#pragma unroll
    for (int a = 0; a < 2; ++a)
#pragma unroll
      for (int b = 0; b < 2; ++b)
#pragma unroll
        for (int m = 0; m < 4; ++m)
#pragma unroll
          for (int n = 0; n < 2; ++n) acc[a][b][m][n] = (f32x4){0.f, 0.f, 0.f, 0.f};
    bf16x8 At[4][2], Bx0[2][2], Bx1[2][2];
    STG8(SB8(0, 0), B0p, 0); STG8(SA8(0, 0), A0, 0); STG8(SB8(0, 1), B1p, 0); STG8(SA8(0, 1), A1, 0);
    if (wr == 1) BAR8;
    WAIT_V(4); BAR8;
    STG8(SB8(1, 0), B0p, 1); STG8(SA8(1, 0), A0, 1); STG8(SB8(1, 1), B1p, 1);
    WAIT_V(6); BAR8;
    for (int t = 0; t < nt - 2; t += 2) {
      LDB8(Bx0, 0, 0); SCHED8; LDA8(At, 0, 0); STG8(SA8(1, 1), A1, t + 1);
      WAIT_L(8); BAR8; WAIT_L(0); MMA8(0, 0, At, Bx0); BAR8; SCHED8;
      LDB8(Bx1, 0, 1); STG8(SB8(0, 0), B0p, t + 2);
      BAR8; WAIT_L(0); MMA8(0, 1, At, Bx1); BAR8;
      LDA8(At, 0, 1); STG8(SA8(0, 0), A0, t + 2);
      BAR8; WAIT_L(0); MMA8(1, 0, At, Bx0); BAR8; SCHED8;
      STG8(SB8(0, 1), B1p, t + 2);
      WAIT_V(6); BAR8; MMA8(1, 1, At, Bx1); BAR8;
      LDB8(Bx0, 1, 0); SCHED8; LDA8(At, 1, 0); STG8(SA8(0, 1), A1, t + 2);
      WAIT_L(8); BAR8; WAIT_L(0); MMA8(0, 0, At, Bx0); BAR8; SCHED8;
      LDB8(Bx1, 1, 1); STG8(SB8(1, 0), B0p, t + 3);
      BAR8; WAIT_L(0); MMA8(0, 1, At, Bx1); BAR8;
      LDA8(At, 1, 1); STG8(SA8(1, 0), A0, t + 3);
      BAR8; WAIT_L(0); MMA8(1, 0, At, Bx0); BAR8; SCHED8;
      STG8(SB8(1, 1), B1p, t + 3);
      WAIT_V(6); BAR8; MMA8(1, 1, At, Bx1); BAR8;
    }
    { LDB8(Bx0, 0, 0); LDA8(At, 0, 0); STG8(SA8(1, 1), A1, nt - 1);
      BAR8; WAIT_L(0); MMA8(0, 0, At, Bx0); BAR8;
      LDB8(Bx1, 0, 1); BAR8; WAIT_L(0); MMA8(0, 1, At, Bx1); BAR8;
      LDA8(At, 0, 1); WAIT_V(4); BAR8; WAIT_L(0); MMA8(1, 0, At, Bx0); MMA8(1, 1, At, Bx1); BAR8; }
    { LDB8(Bx0, 1, 0); LDA8(At, 1, 0); WAIT_V(2); BAR8; WAIT_L(0); MMA8(0, 0, At, Bx0); BAR8;
      LDB8(Bx1, 1, 1); WAIT_V(0); BAR8; WAIT_L(0); MMA8(0, 1, At, Bx1); BAR8;
      LDA8(At, 1, 1); BAR8; WAIT_L(0); MMA8(1, 0, At, Bx0); MMA8(1, 1, At, Bx1); BAR8; }
    if (wr == 0) BAR8;
    {
      int wr_ = wr, wc_ = wc, fr_ = fr, fq_ = fq;
      asm volatile("" : "+v"(wr_), "+v"(wc_), "+v"(fr_), "+v"(fq_));
      epi(acc, pm, pn, wr_, wc_, fr_, fq_, shm);
    }
  }
}

struct EpiIn {
  int l; bf16_t* qkv; float* u; float* out;
  DI void operator()(const f32x4 (&acc)[2][2][4][2], int pm, int pn, int wr, int wc, int fr, int fq, char*) const {
#pragma unroll
    for (int ai = 0; ai < 2; ++ai)
#pragma unroll
      for (int m = 0; m < 4; ++m) {
        const int row = pm * 256 + ai * 128 + wr * 64 + m * 16 + fr;
#pragma unroll
        for (int bj = 0; bj < 2; ++bj)
#pragma unroll
          for (int n = 0; n < 2; ++n) {
            const int col = pn * 256 + bj * 128 + wc * 32 + n * 16 + fq * 4;
            const f32x4 v = acc[ai][bj][m][n];
            if (col < 768) {
              u32x2 o; o.x = pk2(v.x, v.y); o.y = pk2(v.z, v.w);
              *(u32x2*)(qkv + (size_t)row * 768 + col) = o;
              if (col >= 512) {
                const bool isk = col < 640; const int cc = col - (isk ? 512 : 640);
                if (row < MP) {
                  const int t = row & 4095, b = row >> 12;
                  if (t >= 3968) *(f32x4*)(out + (isk ? O_KP : O_VP) + ((size_t)((l * 8 + b) * 128 + (t - 3968))) * 128 + cc) = v;
                } else {
                  const int rs = row - MP, b = rs >> 2, t = rs & 3;
                  *(f32x4*)(out + (isk ? O_KS : O_VS) + ((size_t)((l * 128 + b) * 128 + 124 + t)) * 128 + cc) = v;
                }
              }
            } else {
              *(f32x4*)(u + (size_t)row * 512 + (col - 768)) = v;
            }
          }
      }
  }
};
struct EpiGlu {
  const bf16_t* ssr; bf16_t* ss2; const float* bias;
  DI void operator()(const f32x4 (&acc)[2][2][4][2], int pm, int pn, int wr, int wc, int fr, int fq, char*) const {
#pragma unroll
    for (int ai = 0; ai < 2; ++ai)
#pragma unroll
      for (int m = 0; m < 4; ++m) {
        const int row = pm * 256 + ai * 128 + wr * 64 + m * 16 + fr;
#pragma unroll
        for (int bj = 0; bj < 2; ++bj)
#pragma unroll
          for (int n = 0; n < 2; ++n) {
            const int col = pn * 256 + bj * 128 + wc * 32 + n * 16 + fq * 4;
            const f32x4 v = acc[ai][bj][m][n];
            asm volatile("" ::: "memory");
            const f32x4 bb = *(const f32x4*)(bias + col);
            const u32x2 sv = *(const u32x2*)(ssr + (size_t)row * 512 + col);
            const float s0 = bflo(sv.x), s1 = bfhi(sv.x), s2 = bflo(sv.y), s3 = bfhi(sv.y);
            const float o0 = s0 / (1.f + __expf(-(v.x + bb.x))), o1 = s1 / (1.f + __expf(-(v.y + bb.y)));
            const float o2 = s2 / (1.f + __expf(-(v.z + bb.z))), o3 = s3 / (1.f + __expf(-(v.w + bb.w)));
            u32x2 o; o.x = pk2(o0, o1); o.y = pk2(o2, o3);
            *(u32x2*)(ss2 + (size_t)row * 512 + col) = o;
          }
      }
  }
};
struct EpiRes {
  const float* xp; const float* xs; float* xcur; int from_in;
  DI void operator()(const f32x4 (&acc)[2][2][4][2], int pm, int pn, int wr, int wc, int fr, int fq, char*) const {
#pragma unroll
    for (int ai = 0; ai < 2; ++ai)
#pragma unroll
      for (int m = 0; m < 4; ++m) {
        const int row = pm * 256 + ai * 128 + wr * 64 + m * 16 + fr;
        const float* src = from_in ? (row < MP ? xp + (size_t)row * 1024 : xs + (size_t)(row - MP) * 1024) : xcur + (size_t)row * 1024;
        asm volatile("" ::: "memory");
#pragma unroll
        for (int bj = 0; bj < 2; ++bj)
#pragma unroll
          for (int n = 0; n < 2; ++n) {
            const int col = pn * 256 + bj * 128 + wc * 32 + n * 16 + fq * 4;
            const f32x4 x = *(const f32x4*)(src + col);
            *(f32x4*)(xcur + (size_t)row * 1024 + col) = x + acc[ai][bj][m][n];
          }
      }
  }
};
struct EpiUp {
  int l; bf16_t* act; float* halo; float* ups; const float* conv_w; const float* conv_b; float* out;
  DI void operator()(const f32x4 (&acc)[2][2][4][2], int pm, int pn, int wr, int wc, int fr, int fq, char* shm) const {
    const int chb = pn * 128;
    if (pm >= 128) {
#pragma unroll
      for (int ai = 0; ai < 2; ++ai)
#pragma unroll
        for (int m = 0; m < 4; ++m) {
          const int rs = (pm - 128) * 256 + ai * 128 + wr * 64 + m * 16 + fr;
#pragma unroll
          for (int bj = 0; bj < 2; ++bj)
#pragma unroll
            for (int n = 0; n < 2; ++n) {
              const int c = wc * 32 + n * 16 + fq * 4;
              *(f32x4*)(ups + (size_t)rs * 5376 + (bj ? 2688 : 0) + chb + c) = acc[ai][bj][m][n];
            }
        }
      return;
    }
    bf16_t* S = (bf16_t*)shm;
#pragma unroll
    for (int ai = 0; ai < 2; ++ai)
#pragma unroll
      for (int m = 0; m < 4; ++m) {
        const int R = ai * 128 + wr * 64 + m * 16 + fr;
#pragma unroll
        for (int bj = 0; bj < 2; ++bj)
#pragma unroll
          for (int n = 0; n < 2; ++n) {
            const int c = wc * 32 + n * 16 + fq * 4;
            const f32x4 v = acc[ai][bj][m][n];
            u32x2 o; o.x = pk2(v.x, v.y); o.y = pk2(v.z, v.w);
            *(u32x2*)(S + R * 264 + bj * 128 + c) = o;
            if (((ai == 0 && m == 0) || (ai == 1 && m == 3)) && (R < 2 || R >= 254)) {
              const int hr = R < 2 ? R : R - 252;
              const int oc = (bj ? 2688 : 0) + chb + c;
              *(f32x4*)(halo + ((size_t)(pm * 4 + hr)) * 5376 + oc) = v;
              if (R >= 254 && (pm & 15) == 15) *(f32x4*)(out + O_CP + ((size_t)((l * 8 + (pm >> 4)) * 2 + (R - 254))) * 5376 + oc) = v;
            }
          }
      }
    __syncthreads();
    {
      const int tid = tid_opq(); const int cg8 = (tid & 15) * 8, rbase = tid >> 4;
      const float* cw = conv_w + (size_t)l * 3 * 5376;
      const float* cb = conv_b + (size_t)l * 5376;
      float wa[3][8], wg[3][8], ba[8], bg[8];
#pragma unroll
      for (int i = 0; i < 3; ++i) {
        const f32x4 a0 = *(const f32x4*)(cw + i * 5376 + chb + cg8), a1 = *(const f32x4*)(cw + i * 5376 + chb + cg8 + 4);
        const f32x4 g0 = *(const f32x4*)(cw + i * 5376 + 2688 + chb + cg8), g1 = *(const f32x4*)(cw + i * 5376 + 2688 + chb + cg8 + 4);
        wa[i][0] = a0.x; wa[i][1] = a0.y; wa[i][2] = a0.z; wa[i][3] = a0.w; wa[i][4] = a1.x; wa[i][5] = a1.y; wa[i][6] = a1.z; wa[i][7] = a1.w;
        wg[i][0] = g0.x; wg[i][1] = g0.y; wg[i][2] = g0.z; wg[i][3] = g0.w; wg[i][4] = g1.x; wg[i][5] = g1.y; wg[i][6] = g1.z; wg[i][7] = g1.w;
      }
      {
        const f32x4 a0 = *(const f32x4*)(cb + chb + cg8), a1 = *(const f32x4*)(cb + chb + cg8 + 4);
        const f32x4 g0 = *(const f32x4*)(cb + 2688 + chb + cg8), g1 = *(const f32x4*)(cb + 2688 + chb + cg8 + 4);
        ba[0] = a0.x; ba[1] = a0.y; ba[2] = a0.z; ba[3] = a0.w; ba[4] = a1.x; ba[5] = a1.y; ba[6] = a1.z; ba[7] = a1.w;
        bg[0] = g0.x; bg[1] = g0.y; bg[2] = g0.z; bg[3] = g0.w; bg[4] = g1.x; bg[5] = g1.y; bg[6] = g1.z; bg[7] = g1.w;
      }
#pragma unroll 1
      for (int i = 0; i < 8; ++i) {
        const int R = rbase + 32 * i;
        if (R < 2) continue;
        u32x4 av[3], gv[3];
#pragma unroll
        for (int d = 0; d < 3; ++d) { av[d] = *(const u32x4*)(S + (R - 2 + d) * 264 + cg8); gv[d] = *(const u32x4*)(S + (R - 2 + d) * 264 + 128 + cg8); }
        float res[8];
#pragma unroll
        for (int e = 0; e < 8; ++e) {
          float ca = ba[e], cgv = bg[e];
#pragma unroll
          for (int d = 0; d < 3; ++d) {
            const unsigned aw = av[d][e >> 1], gw = gv[d][e >> 1];
            const float af = (e & 1) ? bfhi(aw) : bflo(aw), gf = (e & 1) ? bfhi(gw) : bflo(gw);
            ca += wa[d][e] * af; cgv += wg[d][e] * gf;
          }
          res[e] = ca * cgv / (1.f + __expf(-cgv));
        }
        u32x4 o; o.x = pk2(res[0], res[1]); o.y = pk2(res[2], res[3]); o.z = pk2(res[4], res[5]); o.w = pk2(res[6], res[7]);
        *(u32x4*)(act + (size_t)(pm * 256 + R) * 2688 + chb + cg8) = o;
      }
    }
    __syncthreads();
  }
};

DI float conv_act(float a0, float a1, float a2, float g0, float g1, float g2, const float* cw, const float* cb, int ch) {
  const float ca = cb[ch] + cw[ch] * a0 + cw[5376 + ch] * a1 + cw[2 * 5376 + ch] * a2;
  const float cgv = cb[2688 + ch] + cw[2688 + ch] * g0 + cw[5376 + 2688 + ch] * g1 + cw[2 * 5376 + 2688 + ch] * g2;
  return ca * cgv / (1.f + __expf(-cgv));
}
DI void fixup_phase(CParams& P, int l) {
  const float* halo = (const float*)(P.ws + WS_HALO);
  const float* ups = (const float*)(P.ws + WS_UPS);
  bf16_t* act = (bf16_t*)(P.ws + WS_ACT);
  const float* cw = P.in[25] + (size_t)l * 3 * 5376;
  const float* cb = P.in[26] + (size_t)l * 5376;
  const float* sconv = P.in[6] + (size_t)l * 128 * 2 * 5376;
  const int gt = blockIdx.x * 512 + tid_opq(), nthr = gridDim.x * 512;
  for (int idx = gt; idx < 128 * 2 * 2688; idx += nthr) {
    const int ch = idx % 2688, i = (idx / 2688) & 1, pm = idx / (2 * 2688);
    const bool first = (pm & 15) == 0;
    const float* cur = halo + (size_t)(pm * 4 + i) * 5376;
    const float* p1 = i == 1 ? halo + (size_t)(pm * 4 + 0) * 5376 : halo + (size_t)((pm - 1) * 4 + 3) * 5376;
    const float* p2 = i == 1 ? halo + (size_t)((pm - 1) * 4 + 3) * 5376 : halo + (size_t)((pm - 1) * 4 + 2) * 5376;
    const bool v1 = (i == 1) || !first, v2 = !first;
    const float a2 = cur[ch], g2 = cur[2688 + ch];
    const float a1 = v1 ? p1[ch] : 0.f, g1 = v1 ? p1[2688 + ch] : 0.f;
    const float a0 = v2 ? p2[ch] : 0.f, g0 = v2 ? p2[2688 + ch] : 0.f;
    const float r = conv_act(a0, a1, a2, g0, g1, g2, cw, cb, ch);
    act[(size_t)(pm * 256 + i) * 2688 + ch] = (bf16_t)(pk2(r, 0.f) & 0xffffu);
  }
  for (int idx = gt; idx < 512 * 2688; idx += nthr) {
    const int ch = idx % 2688, rs = idx / 2688, b = rs >> 2, t = rs & 3;
    const float* cur = ups + (size_t)rs * 5376;
    const float* sc = sconv + (size_t)b * 2 * 5376;
    const float* p1 = t >= 1 ? cur - 5376 : sc + 5376;
    const float* p2 = t >= 2 ? cur - 2 * 5376 : sc + (size_t)t * 5376;
    const float a2 = cur[ch], g2 = cur[2688 + ch];
    const float r = conv_act(p2[ch], p1[ch], a2, p2[2688 + ch], p1[2688 + ch], g2, cw, cb, ch);
    act[(size_t)(MP + rs) * 2688 + ch] = (bf16_t)(pk2(r, 0.f) & 0xffffu);
    if (t >= 2) {
      float* o = P.out + O_CS + ((size_t)((l * 128 + b) * 2 + (t - 2))) * 5376;
      o[ch] = a2; o[2688 + ch] = g2;
    }
  }
}

DI void attn_prompt_unit(CParams& P, int l, int unit, char* shm) {
  const int tid = tid_opq(); const int wid = tid >> 6, lane = tid & 63, fr = lane & 15, fq = lane >> 4;
  const int kvh = unit & 1, qb = (unit >> 1) & 31, b = unit >> 6;
  const bf16_t* qkv = (const bf16_t*)(P.ws + WS_QKV);
  bf16_t* attn = (bf16_t*)(P.ws + WS_ATT);
  bf16_t* Ks = (bf16_t*)shm;
  bf16_t* Vt = (bf16_t*)(shm + 36864);
#pragma unroll
  for (int p = 0; p < 4; ++p) {
    const int key = p * 64 + (tid >> 3), seg = tid & 7, kpos = qb * 128 - 128 + key;
    u32x4 v = (u32x4){0u, 0u, 0u, 0u};
    if (kpos >= 0) v = *(const u32x4*)(qkv + (size_t)(b * 4096 + kpos) * 768 + 512 + kvh * 64 + seg * 8);
    *(u32x4*)(Ks + key * 72 + seg * 8) = v;
  }
#pragma unroll
  for (int p = 0; p < 4; ++p) {
    const int key = p * 64 + (tid & 63), seg = tid >> 6, kpos = qb * 128 - 128 + key;
    u32x4 v = (u32x4){0u, 0u, 0u, 0u};
    if (kpos >= 0) v = *(const u32x4*)(qkv + (size_t)(b * 4096 + kpos) * 768 + 640 + kvh * 64 + seg * 8);
#pragma unroll
    for (int e = 0; e < 4; ++e) {
      Vt[(seg * 8 + 2 * e) * 264 + key] = (bf16_t)(v[e] & 0xffffu);
      Vt[(seg * 8 + 2 * e + 1) * 264 + key] = (bf16_t)(v[e] >> 16);
    }
  }
  __syncthreads();
  const int hh = wid >> 1, half = wid & 1, head = kvh * 4 + hh, q0l = half * 64;
  const float slope2 = exp2f(-(float)(head + 1)) * LOG2E;
  const float sink2 = P.in[9][l * 8 + head] * LOG2E;
  const float scale2 = 0.125f * LOG2E;
  bf16x8 qf[4][2];
#pragma unroll
  for (int qt = 0; qt < 4; ++qt)
#pragma unroll
    for (int kk = 0; kk < 2; ++kk)
      qf[qt][kk] = *(const bf16x8*)(qkv + (size_t)(b * 4096 + qb * 128 + q0l + qt * 16 + fr) * 768 + head * 64 + kk * 32 + fq * 8);
  float mrow[4], lsum[4];
  f32x4 o[4][4];
#pragma unroll
  for (int qt = 0; qt < 4; ++qt) {
    mrow[qt] = sink2; lsum[qt] = fq == 0 ? 1.f : 0.f;
#pragma unroll
    for (int dt = 0; dt < 4; ++dt) o[dt][qt] = (f32x4){0.f, 0.f, 0.f, 0.f};
  }
  for (int kt = 0; kt < 3; ++kt) {
    const int klb = q0l + kt * 64;
    f32x4 s[4][4];
#pragma unroll
    for (int ks = 0; ks < 4; ++ks) {
      const bf16x8 kf0 = *(const bf16x8*)(Ks + (klb + ks * 16 + fr) * 72 + fq * 8);
      const bf16x8 kf1 = *(const bf16x8*)(Ks + (klb + ks * 16 + fr) * 72 + 32 + fq * 8);
#pragma unroll
      for (int qt = 0; qt < 4; ++qt) {
        f32x4 z = (f32x4){0.f, 0.f, 0.f, 0.f};
        z = MFMA16(kf0, qf[qt][0], z);
        s[ks][qt] = MFMA16(kf1, qf[qt][1], z);
      }
    }
    bf16x8 pf[4][2];
#pragma unroll
    for (int qt = 0; qt < 4; ++qt) {
      const int qloc = q0l + qt * 16 + fr;
      float mx = -3.0e38f;
#pragma unroll
      for (int ks = 0; ks < 4; ++ks)
#pragma unroll
        for (int j = 0; j < 4; ++j) {
          const int kl = klb + ks * 16 + fq * 4 + j;
          const int dist = qloc + 128 - kl;
          const bool valid = dist >= 0 && dist < 128 && (qb > 0 || kl >= 128);
          const float val = valid ? s[ks][qt][j] * scale2 - slope2 * (float)dist : -1.0e30f;
          s[ks][qt][j] = val;
          mx = fmaxf(mx, val);
        }
      mx = fmaxf(mx, shx(mx, 16, lane));
      mx = fmaxf(mx, shx(mx, 32, lane));
      const float mnew = fmaxf(mrow[qt], mx);
      const float alpha = exp2f(mrow[qt] - mnew);
      mrow[qt] = mnew;
      float psum = 0.f;
#pragma unroll
      for (int ks = 0; ks < 4; ++ks)
#pragma unroll
        for (int j = 0; j < 4; ++j) { const float pv = exp2f(s[ks][qt][j] - mnew); s[ks][qt][j] = pv; psum += pv; }
      lsum[qt] = lsum[qt] * alpha + psum;
#pragma unroll
      for (int dt = 0; dt < 4; ++dt) o[dt][qt] = o[dt][qt] * alpha;
#pragma unroll
      for (int ksp = 0; ksp < 2; ++ksp) {
        u32x4 pw;
        pw.x = pk2(s[2 * ksp][qt][0], s[2 * ksp][qt][1]); pw.y = pk2(s[2 * ksp][qt][2], s[2 * ksp][qt][3]);
        pw.z = pk2(s[2 * ksp + 1][qt][0], s[2 * ksp + 1][qt][1]); pw.w = pk2(s[2 * ksp + 1][qt][2], s[2 * ksp + 1][qt][3]);
        pf[qt][ksp] = as_bf16x8(pw);
      }
    }
#pragma unroll
    for (int ksp = 0; ksp < 2; ++ksp)
#pragma unroll
      for (int dt = 0; dt < 4; ++dt) {
        const u32x2 v0 = *(const u32x2*)(Vt + (dt * 16 + fr) * 264 + klb + (2 * ksp) * 16 + fq * 4);
        const u32x2 v1 = *(const u32x2*)(Vt + (dt * 16 + fr) * 264 + klb + (2 * ksp + 1) * 16 + fq * 4);
        const bf16x8 vf = as_bf16x8((u32x4){v0.x, v0.y, v1.x, v1.y});
#pragma unroll
        for (int qt = 0; qt < 4; ++qt) o[dt][qt] = MFMA16(vf, pf[qt][ksp], o[dt][qt]);
      }
  }
#pragma unroll
  for (int qt = 0; qt < 4; ++qt) {
    float lt = lsum[qt];
    lt += shx(lt, 16, lane); lt += shx(lt, 32, lane);
    const float inv = 1.f / lt;
    const size_t row = (size_t)(b * 4096 + qb * 128 + q0l + qt * 16 + fr);
#pragma unroll
    for (int dt = 0; dt < 4; ++dt) {
      const f32x4 v = o[dt][qt] * inv;
      u32x2 ov; ov.x = pk2(v.x, v.y); ov.y = pk2(v.z, v.w);
      *(u32x2*)(attn + row * 512 + head * 64 + dt * 16 + fq * 4) = ov;
    }
  }
  __syncthreads();
}

DI void attn_sample_unit(CParams& P, int l, int unit, char* shm) {
  const int tid = tid_opq();
  const int kvh = unit & 1, b = unit >> 1;
  const bf16_t* qkv = (const bf16_t*)(P.ws + WS_QKV);
  bf16_t* attn = (bf16_t*)(P.ws + WS_ATT);
  float* Ksf = (float*)shm;
  float* Vsf = Ksf + 132 * 65;
  float* Qsf = Vsf + 132 * 65;
  float* Ps = Qsf + 16 * 64;
  const float* ck = P.in[2] + (size_t)(l * 128 + b) * 128 * 128;
  const float* cv = P.in[3] + (size_t)(l * 128 + b) * 128 * 128;
  float* okw = P.out + O_KS + (size_t)(l * 128 + b) * 128 * 128;
  float* ovw = P.out + O_VS + (size_t)(l * 128 + b) * 128 * 128;
#pragma unroll 4
  for (int i = 0; i < 16; ++i) {
    const int idx = tid + 512 * i, key = idx >> 6, d = idx & 63;
    const float kv = ck[key * 128 + kvh * 64 + d], vv = cv[key * 128 + kvh * 64 + d];
    Ksf[key * 65 + d] = kv; Vsf[key * 65 + d] = vv;
    if (key >= 4) { okw[(key - 4) * 128 + kvh * 64 + d] = kv; ovw[(key - 4) * 128 + kvh * 64 + d] = vv; }
  }
  if (tid < 256) {
    const int t = tid >> 6, d = tid & 63; const size_t row = (size_t)(MP + b * 4 + t);
    Ksf[(128 + t) * 65 + d] = bf2f(qkv[row * 768 + 512 + kvh * 64 + d]);
    Vsf[(128 + t) * 65 + d] = bf2f(qkv[row * 768 + 640 + kvh * 64 + d]);
  }
#pragma unroll
  for (int i = 0; i < 2; ++i) {
    const int idx = tid + 512 * i, rq = idx >> 6, d = idx & 63, hh = rq >> 2, t = rq & 3;
    Qsf[rq * 64 + d] = bf2f(qkv[(size_t)(MP + b * 4 + t) * 768 + (kvh * 4 + hh) * 64 + d]);
  }
  __syncthreads();
  const int rq = tid >> 5, kl = tid & 31, hh = rq >> 2, t = rq & 3, head = kvh * 4 + hh;
  {
    const float slope = exp2f(-(float)(head + 1));
    const float sink = P.in[9][l * 8 + head];
    float sc[5]; float mx = sink;
#pragma unroll
    for (int i = 0; i < 5; ++i) {
      const int key = kl + 32 * i;
      float val = -1.0e30f;
      if (key < 132) {
        float dot = 0.f;
#pragma unroll 8
        for (int d = 0; d < 64; ++d) dot += Qsf[rq * 64 + d] * Ksf[key * 65 + d];
        const int dist = key < 128 ? (t + 128 - key) : (t - (key - 128));
        if (dist >= 0 && dist < 128) val = dot * 0.125f - slope * (float)dist;
      }
      sc[i] = val; mx = fmaxf(mx, val);
    }
#pragma unroll
    for (int o = 1; o < 32; o <<= 1) mx = fmaxf(mx, shx(mx, o, tid & 63));
    float sum = 0.f;
#pragma unroll
    for (int i = 0; i < 5; ++i) { sc[i] = __expf(sc[i] - mx); sum += sc[i]; }
#pragma unroll
    for (int o = 1; o < 32; o <<= 1) sum += shx(sum, o, tid & 63);
    sum += __expf(sink - mx);
    const float inv = 1.f / sum;
#pragma unroll
    for (int i = 0; i < 5; ++i) { const int key = kl + 32 * i; if (key < 132) Ps[rq * 136 + key] = sc[i] * inv; }
  }
  __syncthreads();
  {
    float a0 = 0.f, a1 = 0.f;
#pragma unroll 4
    for (int key = 0; key < 132; ++key) { const float p = Ps[rq * 136 + key]; a0 += p * Vsf[key * 65 + kl]; a1 += p * Vsf[key * 65 + kl + 32]; }
    const size_t row = (size_t)(MP + b * 4 + t);
    attn[row * 512 + head * 64 + kl] = (bf16_t)(pk2(a0, 0.f) & 0xffffu);
    attn[row * 512 + head * 64 + kl + 32] = (bf16_t)(pk2(a1, 0.f) & 0xffffu);
  }
  __syncthreads();
}

DI void sincos_rev(double ang, float& s, float& c) {
  double r = ang * 0.15915494309189535;
  r -= __builtin_rint(r);
  const float x = (float)(r * 6.283185307179586);
  s = sinf(x); c = cosf(x);
}
DI void s5_item(CParams& P, int l, int mode, int item, char* wl, int lane) {
  int b, c, g;
  g = item & 31;
  if (mode == 2) { b = item >> 5; c = 0; } else { c = (item >> 5) & 7; b = item >> 8; }
  const int n = lane, fr = lane & 15, fq = lane >> 4;
  const int gi = (l * 32 + g) * 64 + n;
  const float lr = P.in[10][gi], li = P.in[11][gi];
  const float dt = expf(P.in[12][l * 32 + g]);
  float lbr, lbi;
  {
    const float mag = expf(lr * dt); float sn, cs; sincos_rev((double)li * (double)dt, sn, cs);
    lbr = mag * cs; lbi = mag * sn;
  }
  float bbr[16], bbi[16];
  {
    const float den = 1.f / (lr * lr + li * li);
    const float e1 = lbr - 1.f;
    const float qr = (e1 * lr + lbi * li) * den, qi = (lbi * lr - e1 * li) * den;
    const float* br = P.in[13] + (size_t)gi * 16; const float* bi = P.in[14] + (size_t)gi * 16;
#pragma unroll
    for (int q = 0; q < 4; ++q) {
      const f32x4 r4 = *(const f32x4*)(br + 4 * q), i4 = *(const f32x4*)(bi + 4 * q);
#pragma unroll
      for (int e = 0; e < 4; ++e) { bbr[4 * q + e] = qr * r4[e] - qi * i4[e]; bbi[4 * q + e] = qr * i4[e] + qi * r4[e]; }
    }
  }
  float sr = 0.f, si = 0.f;
  float* ends = (float*)(P.ws + WS_ENDS);
  if (mode == 2) { const size_t o = ((size_t)(l * 128 + b) * 32 + g) * 64 + n; sr = P.in[4][o]; si = P.in[5][o]; }
  else if (mode == 1 && c > 0) {
    float pr, pi;
    { const float mag = expf(lr * dt * 512.f); float sn, cs; sincos_rev((double)li * (double)dt * 512.0, sn, cs); pr = mag * cs; pi = mag * sn; }
    for (int c2 = 0; c2 < c; ++c2) {
      const float* e = ends + ((size_t)((b * 8 + c2) * 32 + g) * 64 + n) * 2;
      const float er = e[0], ei = e[1];
      const float nr = pr * sr - pi * si + er, ni = pr * si + pi * sr + ei;
      sr = nr; si = ni;
    }
  }
  const int ntok = mode == 2 ? 4 : 512;
  const size_t row0 = mode == 2 ? (size_t)(MP + b * 4) : (size_t)(b * 4096 + c * 512);
  const float* U = (const float*)(P.ws + WS_U);
  bf16_t* ssr = (bf16_t*)(P.ws + WS_SSR);
  float* ul = (float*)wl;
  unsigned* Sl = (unsigned*)(wl + 2048);
  bf16x8 cfrag[4]; f32x4 dsk = (f32x4){0.f, 0.f, 0.f, 0.f};
  if (mode >= 1) {
#pragma unroll
    for (int kk = 0; kk < 4; ++kk) {
      const size_t o = ((size_t)(l * 32 + g) * 16 + fr) * 64 + kk * 16 + fq * 4;
      const f32x4 cr = *(const f32x4*)(P.in[15] + o), ci = *(const f32x4*)(P.in[16] + o);
      u32x4 w; w.x = pk2(cr.x, -ci.x); w.y = pk2(cr.y, -ci.y); w.z = pk2(cr.z, -ci.z); w.w = pk2(cr.w, -ci.w);
      cfrag[kk] = as_bf16x8(w);
    }
    dsk = *(const f32x4*)(P.in[17] + l * 512 + g * 16 + fq * 4);
  } else {
#pragma unroll
    for (int kk = 0; kk < 4; ++kk) cfrag[kk] = as_bf16x8((u32x4){0u, 0u, 0u, 0u});
  }
  const int nsub = (ntok + 15) >> 4;
  f32x4 upre = (f32x4){0.f, 0.f, 0.f, 0.f};
  { const int tok = lane >> 2, seg = lane & 3; if (tok < ntok) upre = *(const f32x4*)(U + (row0 + tok) * 512 + g * 16 + seg * 4); }
  for (int sub = 0; sub < nsub; ++sub) {
    float* uc = ul + (sub & 1) * 256;
    *(f32x4*)(uc + lane * 4) = upre;
    if (sub + 1 < nsub) { const int tok = (sub + 1) * 16 + (lane >> 2), seg = lane & 3; upre = *(const f32x4*)(U + (row0 + tok) * 512 + g * 16 + seg * 4); }
    const int tmax = ntok - sub * 16 < 16 ? ntok - sub * 16 : 16;
#pragma unroll 4
    for (int tt = 0; tt < 16; ++tt) {
      if (tt < tmax) {
        const f32x4 u0 = *(const f32x4*)(uc + tt * 16), u1 = *(const f32x4*)(uc + tt * 16 + 4), u2 = *(const f32x4*)(uc + tt * 16 + 8), u3 = *(const f32x4*)(uc + tt * 16 + 12);
        float bur = 0.f, bui = 0.f;
#pragma unroll
        for (int e = 0; e < 4; ++e) {
          bur += u0[e] * bbr[e]; bui += u0[e] * bbi[e];
          bur += u1[e] * bbr[4 + e]; bui += u1[e] * bbi[4 + e];
          bur += u2[e] * bbr[8 + e]; bui += u2[e] * bbi[8 + e];
          bur += u3[e] * bbr[12 + e]; bui += u3[e] * bbi[12 + e];
        }
        const float nr = lbr * sr - lbi * si + bur, ni = lbr * si + lbi * sr + bui;
        sr = nr; si = ni;
        if (mode >= 1) Sl[tt * 68 + n] = pk2(sr, si);
      }
    }
    if (mode >= 1) {
      f32x4 acc = (f32x4){0.f, 0.f, 0.f, 0.f};
#pragma unroll
      for (int kk = 0; kk < 4; ++kk) {
        const u32x4 sv = *(const u32x4*)(Sl + fr * 68 + kk * 16 + fq * 4);
        acc = MFMA16(cfrag[kk], as_bf16x8(sv), acc);
      }
      if (fr < tmax) {
        const f32x4 u4 = *(const f32x4*)(uc + fr * 16 + fq * 4);
        float y[4];
#pragma unroll
        for (int j = 0; j < 4; ++j) {
          const float x = acc[j] + dsk[j] * u4[j];
          const float z2 = 1.5957691216057308f * (x + 0.044715f * x * x * x);
          y[j] = x / (1.f + __expf(-z2));
        }
        u32x2 ov; ov.x = pk2(y[0], y[1]); ov.y = pk2(y[2], y[3]);
        *(u32x2*)(ssr + (row0 + sub * 16 + fr) * 512 + g * 16 + fq * 4) = ov;
      }
    }
  }
  if (mode == 0) { float* e = ends + ((size_t)((b * 8 + c) * 32 + g) * 64 + n) * 2; e[0] = sr; e[1] = si; }
  else if (mode == 1) { if (c == 7) { const size_t o = ((size_t)(l * 8 + b) * 32 + g) * 64 + n; P.out[O_RP + o] = sr; P.out[O_IP + o] = si; } }
  else { const size_t o = ((size_t)(l * 128 + b) * 32 + g) * 64 + n; P.out[O_RS + o] = sr; P.out[O_IS + o] = si; }
}

DI void merge_phase(CParams& P, int l) {
  const int tid = tid_opq(); const int wid = tid >> 6, lane = tid & 63;
  const bf16_t* attn = (const bf16_t*)(P.ws + WS_ATT);
  const bf16_t* ss2 = (const bf16_t*)(P.ws + WS_SS2);
  bf16_t* h = (bf16_t*)(P.ws + WS_H);
  const float* ga = P.in[20] + l * 512 + lane * 8;
  const float* gs = P.in[21] + l * 512 + lane * 8;
  const f32x4 ga0 = *(const f32x4*)ga, ga1 = *(const f32x4*)(ga + 4), gs0 = *(const f32x4*)gs, gs1 = *(const f32x4*)(gs + 4);
  for (int r = blockIdx.x * 8 + wid; r < MT; r += gridDim.x * 8) {
    const u32x4 av = *(const u32x4*)(attn + (size_t)r * 512 + lane * 8);
    const u32x4 sv = *(const u32x4*)(ss2 + (size_t)r * 512 + lane * 8);
    float a[8], s[8]; float qa = 0.f, qs = 0.f;
#pragma unroll
    for (int e = 0; e < 4; ++e) { a[2 * e] = bflo(av[e]); a[2 * e + 1] = bfhi(av[e]); s[2 * e] = bflo(sv[e]); s[2 * e + 1] = bfhi(sv[e]); }
#pragma unroll
    for (int e = 0; e < 8; ++e) { qa += a[e] * a[e]; qs += s[e] * s[e]; }
    qa = wave_sum(qa, lane); qs = wave_sum(qs, lane);
    const float ra = rsqrtf(qa * (1.f / 512.f) + EPS), rs = rsqrtf(qs * (1.f / 512.f) + EPS);
    u32x4 oa, os;
    oa.x = pk2(a[0] * ra * ga0.x, a[1] * ra * ga0.y); oa.y = pk2(a[2] * ra * ga0.z, a[3] * ra * ga0.w);
    oa.z = pk2(a[4] * ra * ga1.x, a[5] * ra * ga1.y); oa.w = pk2(a[6] * ra * ga1.z, a[7] * ra * ga1.w);
    os.x = pk2(s[0] * rs * gs0.x, s[1] * rs * gs0.y); os.y = pk2(s[2] * rs * gs0.z, s[3] * rs * gs0.w);
    os.z = pk2(s[4] * rs * gs1.x, s[5] * rs * gs1.y); os.w = pk2(s[6] * rs * gs1.z, s[7] * rs * gs1.w);
    *(u32x4*)(h + (size_t)r * 1024 + lane * 8) = oa;
    *(u32x4*)(h + (size_t)r * 1024 + 512 + lane * 8) = os;
  }
}

#define XB_TMO      128
#define XB_XCNT(j)  (256  + 64 * (j))
#define XB_XSUB(j)  (1280 + 64 * (j))
#define XB_XGEN(j)  (2304 + 64 * (j))
#define XB_TOP      3328
#define XB_TOPGEN   3392
#define XCD_BAR_WORDS 3456
#define XB_SPIN_CAP (1u << 18)
#define LAS __attribute__((address_space(3)))
DI unsigned xb_ld(unsigned* p)              { return __hip_atomic_load(p, __ATOMIC_RELAXED, __HIP_MEMORY_SCOPE_AGENT); }
DI unsigned xb_add(unsigned* p, unsigned v) { return __hip_atomic_fetch_add(p, v, __ATOMIC_RELAXED, __HIP_MEMORY_SCOPE_AGENT); }
DI unsigned xb_xcc_id() { return (unsigned)__builtin_amdgcn_s_getreg((3 << 11) | 20) & 0xFu; }
#define XB_SPIN(cond, bar) do { unsigned _sp = 0; while (cond) { __builtin_amdgcn_s_sleep(1); \
    if ((++_sp & 255u) == 0u) { if (xb_ld(&(bar)[XB_TMO])) break; if (_sp > XB_SPIN_CAP) { atomicAdd(&(bar)[XB_TMO], 1u); break; } } } } while (0)
struct XcdBarrier { unsigned* bar; unsigned x; volatile LAS unsigned* st; };
DI XcdBarrier xcd_barrier_post(unsigned* bar, volatile LAS unsigned* st) {
  XcdBarrier b; b.bar = bar; b.x = xb_xcc_id(); b.st = st;
  if (threadIdx.x == 0) (void)xb_add(&bar[XB_XCNT(b.x)], 1u);
  return b;
}
DI void xcd_barrier_complete(unsigned* bar, unsigned x, unsigned& nloc, unsigned& nx) {
  const unsigned G = gridDim.x * gridDim.y * gridDim.z;
  unsigned sum, cnt, mine, sp = 0u;
  for (;;) {
    sum = 0u; cnt = 0u; mine = 0u;
#pragma unroll
    for (unsigned j = 0; j < 16; ++j) { const unsigned c = xb_ld(&bar[XB_XCNT(j)]); sum += c; cnt += (c > 0u) ? 1u : 0u; mine = (j == x) ? c : mine; }
    if (sum == G) break;
    __builtin_amdgcn_s_sleep(1);
    if ((++sp & 255u) == 0u) { if (xb_ld(&bar[XB_TMO])) break; if (sp > XB_SPIN_CAP) { atomicAdd(&bar[XB_TMO], 1u); break; } }
  }
  nloc = mine > 0u ? mine : 1u; nx = cnt > 0u ? cnt : 1u;
}
DI void xcd_barrier(const XcdBarrier& b) {
  asm volatile("s_waitcnt vmcnt(0)" ::: "memory");
  __syncthreads();
  if (threadIdx.x == 0) {
    unsigned* bar = b.bar;
    __builtin_amdgcn_s_waitcnt(0);
    unsigned nloc = b.st[0], nx = b.st[1];
    if (nloc == 0u) { xcd_barrier_complete(bar, b.x, nloc, nx); b.st[0] = nloc; b.st[1] = nx; }
    const unsigned old = xb_add(&bar[XB_XSUB(b.x)], 1u);
    const unsigned gen = old / nloc;
    if (old + 1u == (gen + 1u) * nloc) {
      __builtin_amdgcn_fence(__ATOMIC_RELEASE, "agent");
      asm volatile("s_waitcnt vmcnt(0)" ::: "memory");
      const unsigned og = xb_add(&bar[XB_TOP], 1u);
      const unsigned tg = og / nx;
      if (og + 1u == (tg + 1u) * nx) xb_add(&bar[XB_TOPGEN], 1u);
      else XB_SPIN(xb_ld(&bar[XB_TOPGEN]) == tg, bar);
      __builtin_amdgcn_fence(__ATOMIC_ACQUIRE, "agent");
      xb_add(&bar[XB_XGEN(b.x)], 1u);
      asm volatile("s_waitcnt vmcnt(0)" ::: "memory");
    } else {
      XB_SPIN(xb_ld(&bar[XB_XGEN(b.x)]) == gen, bar);
      __builtin_amdgcn_fence(__ATOMIC_ACQUIRE, "agent");
      asm volatile("s_waitcnt vmcnt(0)" ::: "memory");
    }
  }
  __syncthreads();
}

#ifndef SKIP_MASK
#define SKIP_MASK 0
#endif
#ifndef DOUBLE_MASK
#define DOUBLE_MASK 0
#endif
#define PH(x) for (int rep_ = 0; rep_ < (((DOUBLE_MASK >> (x)) & 1) ? 2 : 1); ++rep_) if constexpr (!((SKIP_MASK >> (x)) & 1))
#define GSYNC xcd_barrier(xb)
#ifndef GEMMFN
#define GEMMFN gemm_phase8
#endif
template <int l>
DI void layer_body(CParams* kp, char* shm, const XcdBarrier& xb) {
#define P (*launder(kp))
  const int nblk = gridDim.x;
  bf16_t* wt0 = (bf16_t*)(P.ws + WS_WT);
  bf16_t* hbuf = (bf16_t*)(P.ws + WS_H);
  float* xcur = (float*)(P.ws + WS_X);

    const bf16_t* wt = wt0 + (size_t)l * WT_LAYER;
    PH(1) {
      EpiIn e; e.l = l; e.qkv = (bf16_t*)(P.ws + WS_QKV); e.u = (float*)(P.ws + WS_U); e.out = P.out;
      GEMMFN(hbuf, wt + WT_IN, 130, 5, 1024, e, shm);
    }
    GSYNC;
    {
      PH(2) for (int u = blockIdx.x; u < 512; u += nblk) attn_prompt_unit(P, l, u, shm);
      PH(3) for (int u = blockIdx.x; u < 256; u += nblk) attn_sample_unit(P, l, u, shm);
      const int tq = tid_opq(); const int wv = __builtin_amdgcn_readfirstlane(tq >> 6), lane = tq & 63;
      PH(4) for (int it = blockIdx.x * 8 + wv; it < 2048; it += nblk * 8) s5_item(P, l, 0, it, shm + wv * 6656, lane);
    }
    GSYNC;
    {
      const int tq = tid_opq(); const int wv = __builtin_amdgcn_readfirstlane(tq >> 6), lane = tq & 63;
      PH(5) for (int it = blockIdx.x * 8 + wv; it < 2048; it += nblk * 8) s5_item(P, l, 1, it, shm + wv * 6656, lane);
      PH(6) for (int it = blockIdx.x * 8 + wv; it < 4096; it += nblk * 8) s5_item(P, l, 2, it, shm + wv * 6656, lane);
    }
    GSYNC;
    PH(7) {
      EpiGlu e; e.ssr = (const bf16_t*)(P.ws + WS_SSR); e.ss2 = (bf16_t*)(P.ws + WS_SS2); e.bias = P.in[19] + l * 512;
      GEMMFN((const bf16_t*)(P.ws + WS_SSR), wt + WT_GLU, 130, 2, 512, e, shm);
    }
    GSYNC;
    PH(8) merge_phase(P, l);
    GSYNC;
    PH(9) {
      EpiRes e; e.xp = P.in[0]; e.xs = P.in[1]; e.xcur = xcur; e.from_in = (l == 0);
      GEMMFN(hbuf, wt + WT_OUT, 130, 4, 1024, e, shm);
    }
    GSYNC;
    PH(10) norm_phase(P, 1, P.in[23] + l * 1024);
    GSYNC;
    PH(11) {
      EpiUp e; e.l = l; e.act = (bf16_t*)(P.ws + WS_ACT); e.halo = (float*)(P.ws + WS_HALO); e.ups = (float*)(P.ws + WS_UPS);
      e.conv_w = P.in[25]; e.conv_b = P.in[26]; e.out = P.out;
      GEMMFN(hbuf, wt + WT_UP, 130, 21, 1024, e, shm);
    }
    GSYNC;
    PH(12) fixup_phase(P, l);
    GSYNC;
    PH(13) {
      EpiRes e; e.xp = P.in[0]; e.xs = P.in[1]; e.xcur = xcur; e.from_in = 0;
      GEMMFN((const bf16_t*)(P.ws + WS_ACT), wt + WT_DOWN, 130, 4, 2688, e, shm);
    }
    GSYNC;
    if (l == 0) { norm_phase(P, 1, P.in[7] + 1024); GSYNC; }
    else final_norm_phase(P);
#undef P
}
__global__ void __launch_bounds__(512) mega(Params Parg) {
  extern __shared__ __attribute__((aligned(16))) char shm[];
  CParams* kp = (CParams*)__builtin_amdgcn_kernarg_segment_ptr();
  cg::grid_group grid = cg::this_grid();
  volatile LAS unsigned* xst = (volatile LAS unsigned*)(shm + LDS_BYTES - 16);
  if (threadIdx.x == 0) { xst[0] = 0u; xst[1] = 0u; }
  __syncthreads();
  const XcdBarrier xb = xcd_barrier_post((unsigned*)((*launder(kp)).ws + WS_BAR), xst);
  PH(0) phase0(*launder(kp), shm);
  grid.sync();
  layer_body<0>(kp, shm, xb);
  layer_body<1>(kp, shm, xb);
}
extern "C" void kernel_launch(void* const* d_in, const int* in_sizes, int n_in, void* d_out, int out_size, void* d_ws, size_t ws_size, hipStream_t stream) {
  static int grid_blocks = 0;
  if (grid_blocks == 0) {
    if (n_in != 29 || ws_size < WS_TOTAL) { fprintf(stderr, "kernel_launch: unexpected n_in %d or ws_size %zu (< %zu)\n", n_in, ws_size, (size_t)WS_TOTAL); grid_blocks = -1; return; }
    int dev = 0, cus = 0, per_cu = 0;
    hipGetDevice(&dev);
    hipDeviceGetAttribute(&cus, hipDeviceAttributeMultiprocessorCount, dev);
    hipFuncSetAttribute((const void*)mega, hipFuncAttributeMaxDynamicSharedMemorySize, LDS_BYTES);
    hipOccupancyMaxActiveBlocksPerMultiprocessor(&per_cu, (const void*)mega, 512, LDS_BYTES);
    if (per_cu < 1) per_cu = 1;
    if (per_cu > 1) per_cu = 1;
    grid_blocks = cus * per_cu;
  }
  if (grid_blocks < 0) return;
  Params p{};
  for (int i = 0; i < 29; ++i) p.in[i] = (const float*)d_in[i];
  p.out = (float*)d_out;
  p.ws = (char*)d_ws;
  (void)hipMemsetAsync((char*)d_ws + WS_BAR, 0, XCD_BAR_WORDS * 4, stream);
  void* args[] = {&p};
  hipError_t e = hipLaunchCooperativeKernel((const void*)mega, dim3(grid_blocks), dim3(512), args, LDS_BYTES, stream);
  if (e != hipSuccess) fprintf(stderr, "cooperative launch failed: %s (grid %d)\n", hipGetErrorString(e), grid_blocks);
}
```

```cpp
#include <hip/hip_runtime.h>
#include <hip/hip_cooperative_groups.h>
#include <cstdint>
#include <cstdio>
namespace cg = cooperative_groups;

#define DI __device__ __forceinline__
typedef unsigned short bf16_t;
typedef short bf16x8 __attribute__((ext_vector_type(8)));
typedef float f32x4 __attribute__((ext_vector_type(4)));
typedef unsigned u32x4 __attribute__((ext_vector_type(4)));
typedef unsigned u32x2 __attribute__((ext_vector_type(2)));

constexpr int MP = 32768, MT = 33280;
constexpr float EPS = 1e-5f;
constexpr float LOG2E = 1.4426950408889634f;

constexpr size_t O_Y = 0, O_KP = 34078720, O_VP = 34340864, O_RP = 34603008, O_IP = 34635776, O_CP = 34668544,
                 O_KS = 34840576, O_VS = 39034880, O_RS = 43229184, O_IS = 43753472, O_CS = 44277760;
constexpr size_t WS_WT = 0, WS_H = 43515904, WS_X = 111673344, WS_R = 247988224;
constexpr size_t WS_QKV = WS_R, WS_U = WS_R + 51118080, WS_ATT = WS_R + 119275520, WS_SSR = WS_R + 153354240, WS_SS2 = WS_R + 187432960;
constexpr size_t WS_ACT = WS_R;
constexpr size_t WS_HALO = 469499904, WS_UPS = 480509952, WS_ENDS = 491520000, WS_BAR = 492568576, WS_TOTAL = 492568576 + 16384;
constexpr size_t WT_IN = 0, WT_GLU = 1310720, WT_OUT = 1572864, WT_UP = 2621440, WT_DOWN = 8126464, WT_LAYER = 10878976;
constexpr int LDS_BYTES = 136 * 1024;

struct Params {
  const float* in[29];
  float* out;
  char* ws;
};

typedef const __attribute__((address_space(4))) Params CParams;
DI CParams* launder(CParams* p) { asm volatile("" : "+s"(p)); return p; }
DI unsigned pk2(float lo, float hi) { unsigned r; asm("v_cvt_pk_bf16_f32 %0, %1, %2" : "=v"(r) : "v"(lo), "v"(hi)); return r; }
DI float bflo(unsigned u) { return __uint_as_float(u << 16); }
DI float bfhi(unsigned u) { return __uint_as_float(u & 0xffff0000u); }
DI float bf2f(bf16_t b) { return __uint_as_float(((unsigned)b) << 16); }
DI float shx(float v, int o, int lane) { return __int_as_float(__builtin_amdgcn_ds_bpermute((lane ^ o) << 2, __float_as_int(v))); }
DI float wave_sum(float v, int lane) {
#pragma unroll
  for (int o = 1; o < 64; o <<= 1) v += shx(v, o, lane);
  return v;
}
DI int tid_opq() { int t = threadIdx.x; asm volatile("" : "+v"(t)); return t; }
DI bf16x8 as_bf16x8(u32x4 v) { return __builtin_bit_cast(bf16x8, v); }
#define MFMA16(a, b, c) __builtin_amdgcn_mfma_f32_16x16x32_bf16((a), (b), (c), 0, 0, 0)

DI void transpose_item(const float* __restrict__ W, int K, int N, bf16_t* __restrict__ WT, int item, float* scr, int tid, bool perm_up) {
  const int nblk = N / 64, kb = item / nblk, nb = item % nblk, k0 = kb * 64, n0 = nb * 64;
  int src_n0 = n0;
  if (perm_up) { const int tile = n0 >> 8, j = n0 & 255; src_n0 = (j < 128) ? tile * 128 + j : 2688 + tile * 128 + (j - 128); }
#pragma unroll
  for (int i = 0; i < 8; ++i) { const int kk = (tid >> 6) + 8 * i, nn = tid & 63; scr[kk * 65 + nn] = W[(size_t)(k0 + kk) * N + src_n0 + nn]; }
  __syncthreads();
  {
    const int nn = tid >> 3, c = tid & 7;
    const float* s = scr + (8 * c) * 65 + nn;
    u32x4 o;
    o.x = pk2(s[0 * 65], s[1 * 65]); o.y = pk2(s[2 * 65], s[3 * 65]); o.z = pk2(s[4 * 65], s[5 * 65]); o.w = pk2(s[6 * 65], s[7 * 65]);
    *(u32x4*)(WT + (size_t)(n0 + nn) * K + k0 + 8 * c) = o;
  }
  __syncthreads();
}

DI void norm_row_bf16(const float* __restrict__ xr, const float* __restrict__ g, bf16_t* __restrict__ orow, int lane) {
  f32x4 v[4]; float s = 0.f;
#pragma unroll
  for (int j = 0; j < 4; ++j) { v[j] = ((const f32x4*)xr)[lane + 64 * j]; s += v[j].x * v[j].x + v[j].y * v[j].y + v[j].z * v[j].z + v[j].w * v[j].w; }
  s = wave_sum(s, lane);
  const float rstd = rsqrtf(s * (1.f / 1024.f) + EPS);
#pragma unroll
  for (int j = 0; j < 4; ++j) {
    const f32x4 gg = ((const f32x4*)g)[lane + 64 * j];
    u32x2 o; o.x = pk2(v[j].x * rstd * gg.x, v[j].y * rstd * gg.y); o.y = pk2(v[j].z * rstd * gg.z, v[j].w * rstd * gg.w);
    ((u32x2*)orow)[lane + 64 * j] = o;
  }
}
DI void norm_row_f32(const float* __restrict__ xr, const float* __restrict__ g, float* __restrict__ orow, int lane) {
  f32x4 v[4]; float s = 0.f;
#pragma unroll
  for (int j = 0; j < 4; ++j) { v[j] = ((const f32x4*)xr)[lane + 64 * j]; s += v[j].x * v[j].x + v[j].y * v[j].y + v[j].z * v[j].z + v[j].w * v[j].w; }
  s = wave_sum(s, lane);
  const float rstd = rsqrtf(s * (1.f / 1024.f) + EPS);
#pragma unroll
  for (int j = 0; j < 4; ++j) {
    const f32x4 gg = ((const f32x4*)g)[lane + 64 * j];
    f32x4 o; o.x = v[j].x * rstd * gg.x; o.y = v[j].y * rstd * gg.y; o.z = v[j].z * rstd * gg.z; o.w = v[j].w * rstd * gg.w;
    ((f32x4*)orow)[lane + 64 * j] = o;
  }
}
DI const float* xrow_in(CParams& P, int r) { return r < MP ? P.in[0] + (size_t)r * 1024 : P.in[1] + (size_t)(r - MP) * 1024; }

DI void norm_phase(CParams& P, int mode, const float* g) {
  const int tid = tid_opq(); const int wid = tid >> 6, lane = tid & 63;
  const float* xcur = (const float*)(P.ws + WS_X);
  bf16_t* h = (bf16_t*)(P.ws + WS_H);
  for (int r = blockIdx.x * 8 + wid; r < MT; r += gridDim.x * 8) {
    const float* xr = mode == 0 ? xrow_in(P, r) : xcur + (size_t)r * 1024;
    norm_row_bf16(xr, g, h + (size_t)r * 1024, lane);
  }
}
DI void final_norm_phase(CParams& P) {
  const int tid = tid_opq(); const int wid = tid >> 6, lane = tid & 63;
  const float* xcur = (const float*)(P.ws + WS_X);
  for (int r = blockIdx.x * 8 + wid; r < MT; r += gridDim.x * 8)
    norm_row_f32(xcur + (size_t)r * 1024, P.in[28], P.out + O_Y + (size_t)r * 1024, lane);
}

DI void phase0(CParams& P, char* shm) {
  const int tid = tid_opq();
  constexpr int per_layer = 320 + 64 + 256 + 1344 + 672;
  bf16_t* wt0 = (bf16_t*)(P.ws + WS_WT);
  for (int it = blockIdx.x; it < 2 * per_layer; it += gridDim.x) {
    const int l = it / per_layer; int r = it % per_layer;
    bf16_t* wt = wt0 + (size_t)l * WT_LAYER;
    if (r < 320) { transpose_item(P.in[8] + (size_t)l * 1024 * 1280, 1024, 1280, wt + WT_IN, r, (float*)shm, tid, false); continue; }
    r -= 320;
    if (r < 64) { transpose_item(P.in[18] + (size_t)l * 512 * 512, 512, 512, wt + WT_GLU, r, (float*)shm, tid, false); continue; }
    r -= 64;
    if (r < 256) { transpose_item(P.in[22] + (size_t)l * 1024 * 1024, 1024, 1024, wt + WT_OUT, r, (float*)shm, tid, false); continue; }
    r -= 256;
    if (r < 1344) { transpose_item(P.in[24] + (size_t)l * 1024 * 5376, 1024, 5376, wt + WT_UP, r, (float*)shm, tid, true); continue; }
    r -= 1344;
    transpose_item(P.in[27] + (size_t)l * 2688 * 1024, 2688, 1024, wt + WT_DOWN, r, (float*)shm, tid, false);
  }
  norm_phase(P, 0, P.in[7]);
}

DI int lds_byte(int r, int c) { const int st = (r >> 4) * 2 + (c >> 5), rr = r & 15, cc = c & 31, ob = rr * 64 + cc * 2; return st * 1024 + (ob ^ (((ob >> 9) & 1) << 5)); }
DI void stage_rc(int b, int& R, int& C) { const int st = b / 1024, sb = b % 1024, swz = sb ^ (((sb >> 9) & 1) << 5); R = (st >> 1) * 16 + swz / 64; C = (st & 1) * 32 + (swz % 64) / 2; }
DI void gl_lds16(const void* g, void* l) {
  __builtin_amdgcn_global_load_lds((const __attribute__((address_space(1))) void*)g, (__attribute__((address_space(3))) void*)l, 16, 0, 0);
}

template <class Epi>
DI void gemm_phase(const bf16_t* __restrict__ A, const bf16_t* __restrict__ Bt, int nM, int nN, int K, const Epi& epi, char* shm) {
  const int tid = tid_opq(); const int wid = tid >> 6, lane = tid & 63, wr = wid >> 2, wc = wid & 3, fr = lane & 15, fq = lane >> 4;
  const int nt = K / 64, ntiles = nM * nN;
  int sr0, sc0, sr1, sc1; stage_rc(tid * 16, sr0, sc0); stage_rc(tid * 16 + 8192, sr1, sc1);
  const unsigned go0 = (unsigned)(sr0 * K + sc0) * 2u, go1 = (unsigned)(sr1 * K + sc1) * 2u;
  const unsigned goh = (unsigned)(128 * K) * 2u;
  const int lob = fr * 64 + fq * 16;
  const int lswz = lob ^ (((lob >> 9) & 1) << 5);
  char* const a_base = shm + lswz + wr * 8192;
  char* const b_base = shm + 65536 + lswz + wc * 4096;
  char* const st_base = shm + tid * 16;
  for (int tile = blockIdx.x; tile < ntiles; tile += gridDim.x) {
    const int pm = tile / nN, pn = tile % nN;
    const char* Ab = (const char*)(A + (size_t)pm * 256 * K);
    const char* Bb = (const char*)(Bt + (size_t)pn * 256 * K);
    f32x4 acc[2][2][4][2];
#pragma unroll
    for (int a = 0; a < 2; ++a)
#pragma unroll
      for (int b = 0; b < 2; ++b)
#pragma unroll
        for (int m = 0; m < 4; ++m)
#pragma unroll
          for (int n = 0; n < 2; ++n) acc[a][b][m][n] = (f32x4){0.f, 0.f, 0.f, 0.f};

#define GEMM_STAGE(buf, kt)                                                         \
  do {                                                                              \
    const char* ak_ = Ab + (size_t)(kt) * 128;                                      \
    const char* bk_ = Bb + (size_t)(kt) * 128;                                      \
    char* la_ = st_base + (buf) * 32768;                                            \
    gl_lds16(ak_ + go0, la_);                                                       \
    gl_lds16(ak_ + go1, la_ + 8192);                                                \
    gl_lds16(ak_ + goh + go0, la_ + 16384);                                         \
    gl_lds16(ak_ + goh + go1, la_ + 16384 + 8192);                                  \
    gl_lds16(bk_ + go0, la_ + 65536);                                               \
    gl_lds16(bk_ + go1, la_ + 65536 + 8192);                                        \
    gl_lds16(bk_ + goh + go0, la_ + 65536 + 16384);                                 \
    gl_lds16(bk_ + goh + go1, la_ + 65536 + 16384 + 8192);                          \
  } while (0)

    GEMM_STAGE(0, 0);
    asm volatile("s_waitcnt vmcnt(0)" ::: "memory");
    __syncthreads();
    for (int t = 0; t < nt; ++t) {
      const int cur = t & 1;
      if (t + 1 < nt) GEMM_STAGE(cur ^ 1, t + 1);
      const char* ac = a_base + cur * 32768;
      const char* bc = b_base + cur * 32768;
      bf16x8 Bf[2][2][2];
#pragma unroll
      for (int bj = 0; bj < 2; ++bj)
#pragma unroll
        for (int n = 0; n < 2; ++n)
#pragma unroll
          for (int k = 0; k < 2; ++k) Bf[bj][n][k] = *(const bf16x8*)(bc + bj * 16384 + n * 2048 + k * 1024);
#pragma unroll
      for (int ai = 0; ai < 2; ++ai) {
        bf16x8 At[4][2];
        if (ai == 1) __builtin_amdgcn_sched_barrier(0);
#pragma unroll
        for (int m = 0; m < 4; ++m)
#pragma unroll
          for (int k = 0; k < 2; ++k) At[m][k] = *(const bf16x8*)(ac + ai * 16384 + m * 2048 + k * 1024);
#pragma unroll
        for (int bj = 0; bj < 2; ++bj)
#pragma unroll
          for (int m = 0; m < 4; ++m)
#pragma unroll
            for (int n = 0; n < 2; ++n)
#pragma unroll
              for (int k = 0; k < 2; ++k) acc[ai][bj][m][n] = MFMA16(Bf[bj][n][k], At[m][k], acc[ai][bj][m][n]);
      }
      asm volatile("s_waitcnt vmcnt(0)" ::: "memory");
      __syncthreads();
    }
    {
      int wr_ = wr, wc_ = wc, fr_ = fr, fq_ = fq;
      asm volatile("" : "+v"(wr_), "+v"(wc_), "+v"(fr_), "+v"(fq_));
      epi(acc, pm, pn, wr_, wc_, fr_, fq_, shm, false);
    }
  }
}

template <class Epi>
DI void gemm_phase8(const bf16_t* __restrict__ A, const bf16_t* __restrict__ Bt, int nM, int nN, int K, const Epi& epi, char* shm, int nfull = -1, int S = 1) {
  const int tid = tid_opq(); const int wid = tid >> 6, lane = tid & 63, wr = wid >> 2, wc = wid & 3, fr = lane & 15, fq = lane >> 4;
  const int ntk = K / 64, ntiles = nM * nN;
  if (nfull < 0) nfull = ntiles;
  const int nitems = nfull + (ntiles - nfull) * S;
  int sr0, sc0, sr1, sc1; stage_rc(tid * 16, sr0, sc0); stage_rc(tid * 16 + 8192, sr1, sc1);
  const unsigned go0 = (unsigned)(sr0 * K + sc0) * 2u, go1 = (unsigned)(sr1 * K + sc1) * 2u;
  const unsigned goh = (unsigned)(128 * K) * 2u;
  const int lob = fr * 64 + fq * 16;
  const int lswz = lob ^ (((lob >> 9) & 1) << 5);
  char* const a_base = shm + lswz + wr * 8192;
  char* const b_base = shm + 65536 + lswz + wc * 4096;
  const int wave_s = __builtin_amdgcn_readfirstlane(wid);
  char* const st_base = shm + wave_s * 1024;
#define SA8(b, h) (((b) * 2 + (h)) * 16384)
#define SB8(b, h) ((4 + (b) * 2 + (h)) * 16384)
#define STG8(ldsoff, panel, kt) do { const char* g_ = (panel) + (size_t)(kt) * 128; asm volatile("" : "+s"(g_)); gl_lds16(g_ + go0, st_base + (ldsoff)); gl_lds16(g_ + go1, st_base + (ldsoff) + 8192); } while (0)
#define LDA8(dst, b, h) _Pragma("unroll") for (int m = 0; m < 4; ++m) _Pragma("unroll") for (int k = 0; k < 2; ++k) dst[m][k] = *(const bf16x8*)(a_base + SA8(b, h) + m * 2048 + k * 1024)
#define LDB8(dst, b, h) _Pragma("unroll") for (int n = 0; n < 2; ++n) _Pragma("unroll") for (int k = 0; k < 2; ++k) dst[n][k] = *(const bf16x8*)(b_base + ((b) * 2 + (h)) * 16384 + n * 2048 + k * 1024)
#define MMA8(ai, bj, Ax, Bx) do { __builtin_amdgcn_s_setprio(1); \
    _Pragma("unroll") for (int m = 0; m < 4; ++m) _Pragma("unroll") for (int n = 0; n < 2; ++n) _Pragma("unroll") for (int k = 0; k < 2; ++k) \
      acc[ai][bj][m][n] = MFMA16(Bx[n][k], Ax[m][k], acc[ai][bj][m][n]); \
    __builtin_amdgcn_s_setprio(0); } while (0)
#define WAIT_V(n) asm volatile("s_waitcnt vmcnt(" #n ")" ::: "memory")
#define WAIT_L(n) asm volatile("s_waitcnt lgkmcnt(" #n ")" ::: "memory")
#define BAR8 __builtin_amdgcn_s_barrier()
#define SCHED8 __builtin_amdgcn_sched_barrier(0)
  for (int item = blockIdx.x; item < nitems; item += gridDim.x) {
    int tile = item, ks = 0, nt = ntk, pm, pn;
    if (item >= nfull) { tile = nfull + (item - nfull) / S; ks = (item - nfull) % S; nt = ntk / S; pm = tile / nN; pn = tile % nN; }
    else {
      const int q = nfull / 8, r = nfull % 8, xcd = item % 8, off = item / 8;
      const int w = (xcd < r ? xcd * (q + 1) : r * (q + 1) + (xcd - r) * q) + off;
      const int nMf = nfull / nN, nig = 8 * nN, gid = w / nig, fm = gid * 8, gsz = (nMf - fm) < 8 ? (nMf - fm) : 8;
      pm = fm + (w % nig) % gsz; pn = (w % nig) / gsz;
    }
    const char* A0 = (const char*)(A + (size_t)pm * 256 * K) + (size_t)ks * nt * 128;
    const char* A1 = A0 + goh;
    const char* B0p = (const char*)(Bt + (size_t)pn * 256 * K) + (size_t)ks * nt * 128;
    const char* B1p = B0p + goh;
    f32x4 acc[2][2][4][2];
#pragma unroll
    for (int a = 0; a < 2; ++a)
#pragma unroll
      for (int b = 0; b < 2; ++b)
#pragma unroll
        for (int m = 0; m < 4; ++m)
#pragma unroll
          for (int n = 0; n < 2; ++n) acc[a][b][m][n] = (f32x4){0.f, 0.f, 0.f, 0.f};
    bf16x8 At[4][2], Bx0[2][2], Bx1[2][2];
    STG8(SB8(0, 0), B0p, 0); STG8(SA8(0, 0), A0, 0); STG8(SB8(0, 1), B1p, 0); STG8(SA8(0, 1), A1, 0);
    if (wr == 1) BAR8;
    WAIT_V(4); BAR8;
    STG8(SB8(1, 0), B0p, 1); STG8(SA8(1, 0), A0, 1); STG8(SB8(1, 1), B1p, 1);
    WAIT_V(6); BAR8;
    for (int t = 0; t < nt - 2; t += 2) {
      LDB8(Bx0, 0, 0); SCHED8; LDA8(At, 0, 0); STG8(SA8(1, 1), A1, t + 1);
      WAIT_L(8); BAR8; WAIT_L(0); MMA8(0, 0, At, Bx0); BAR8; SCHED8;
      LDB8(Bx1, 0, 1); STG8(SB8(0, 0), B0p, t + 2);
      BAR8; WAIT_L(0); MMA8(0, 1, At, Bx1); BAR8;
      LDA8(At, 0, 1); STG8(SA8(0, 0), A0, t + 2);
      BAR8; WAIT_L(0); MMA8(1, 0, At, Bx0); BAR8; SCHED8;
      STG8(SB8(0, 1), B1p, t + 2);
      WAIT_V(6); BAR8; MMA8(1, 1, At, Bx1); BAR8;
      LDB8(Bx0, 1, 0); SCHED8; LDA8(At, 1, 0); STG8(SA8(0, 1), A1, t + 2);
      WAIT_L(8); BAR8; WAIT_L(0); MMA8(0, 0, At, Bx0); BAR8; SCHED8;
      LDB8(Bx1, 1, 1); STG8(SB8(1, 0), B0p, t + 3);
      BAR8; WAIT_L(0); MMA8(0, 1, At, Bx1); BAR8;
      LDA8(At, 1, 1); STG8(SA8(1, 0), A0, t + 3);
      BAR8; WAIT_L(0); MMA8(1, 0, At, Bx0); BAR8; SCHED8;
      STG8(SB8(1, 1), B1p, t + 3);
      WAIT_V(6); BAR8; MMA8(1, 1, At, Bx1); BAR8;
    }
    { LDB8(Bx0, 0, 0); LDA8(At, 0, 0); STG8(SA8(1, 1), A1, nt - 1);
      BAR8; WAIT_L(0); MMA8(0, 0, At, Bx0); BAR8;
      LDB8(Bx1, 0, 1); BAR8; WAIT_L(0); MMA8(0, 1, At, Bx1); BAR8;
      LDA8(At, 0, 1); WAIT_V(4); BAR8; WAIT_L(0); MMA8(1, 0, At, Bx0); MMA8(1, 1, At, Bx1); BAR8; }
    { LDB8(Bx0, 1, 0); LDA8(At, 1, 0); WAIT_V(2); BAR8; WAIT_L(0); MMA8(0, 0, At, Bx0); BAR8;
      LDB8(Bx1, 1, 1); WAIT_V(0); BAR8; WAIT_L(0); MMA8(0, 1, At, Bx1); BAR8;
      LDA8(At, 1, 1); BAR8; WAIT_L(0); MMA8(1, 0, At, Bx0); MMA8(1, 1, At, Bx1); BAR8; }
    if (wr == 0) BAR8;
    {
      int wr_ = wr, wc_ = wc, fr_ = fr, fq_ = fq;
      asm volatile("" : "+v"(wr_), "+v"(wc_), "+v"(fr_), "+v"(fq_));
      epi(acc, pm, pn, wr_, wc_, fr_, fq_, shm, item >= nfull);
    }
  }
}

struct EpiIn {
  int l; bf16_t* qkv; float* u; float* out;
  DI void operator()(const f32x4 (&acc)[2][2][4][2], int pm, int pn, int wr, int wc, int fr, int fq, char*, bool atomic) const {
#pragma unroll
    for (int ai = 0; ai < 2; ++ai)
#pragma unroll
      for (int m = 0; m < 4; ++m) {
        const int row = pm * 256 + ai * 128 + wr * 64 + m * 16 + fr;
#pragma unroll
        for (int bj = 0; bj < 2; ++bj)
#pragma unroll
          for (int n = 0; n < 2; ++n) {
            const int col = pn * 256 + bj * 128 + wc * 32 + n * 16 + fq * 4;
            const f32x4 v = acc[ai][bj][m][n];
            if (col < 768) {
              u32x2 o; o.x = pk2(v.x, v.y); o.y = pk2(v.z, v.w);
              *(u32x2*)(qkv + (size_t)row * 768 + col) = o;
              if (col >= 512) {
                const bool isk = col < 640; const int cc = col - (isk ? 512 : 640);
                if (row < MP) {
                  const int t = row & 4095, b = row >> 12;
                  if (t >= 3968) *(f32x4*)(out + (isk ? O_KP : O_VP) + ((size_t)((l * 8 + b) * 128 + (t - 3968))) * 128 + cc) = v;
                } else {
                  const int rs = row - MP, b = rs >> 2, t = rs & 3;
                  *(f32x4*)(out + (isk ? O_KS : O_VS) + ((size_t)((l * 128 + b) * 128 + 124 + t)) * 128 + cc) = v;
                }
              }
            } else {
              *(f32x4*)(u + (size_t)row * 512 + (col - 768)) = v;
            }
          }
      }
  }
};
struct EpiGlu {
  const bf16_t* ssr; bf16_t* ss2; const float* bias;
  DI void operator()(const f32x4 (&acc)[2][2][4][2], int pm, int pn, int wr, int wc, int fr, int fq, char*, bool atomic) const {
#pragma unroll
    for (int ai = 0; ai < 2; ++ai)
#pragma unroll
      for (int m = 0; m < 4; ++m) {
        const int row = pm * 256 + ai * 128 + wr * 64 + m * 16 + fr;
#pragma unroll
        for (int bj = 0; bj < 2; ++bj)
#pragma unroll
          for (int n = 0; n < 2; ++n) {
            const int col = pn * 256 + bj * 128 + wc * 32 + n * 16 + fq * 4;
            const f32x4 v = acc[ai][bj][m][n];
            asm volatile("" ::: "memory");
            const f32x4 bb = *(const f32x4*)(bias + col);
            const u32x2 sv = *(const u32x2*)(ssr + (size_t)row * 512 + col);
            const float s0 = bflo(sv.x), s1 = bfhi(sv.x), s2 = bflo(sv.y), s3 = bfhi(sv.y);
            const float o0 = s0 / (1.f + __expf(-(v.x + bb.x))), o1 = s1 / (1.f + __expf(-(v.y + bb.y)));
            const float o2 = s2 / (1.f + __expf(-(v.z + bb.z))), o3 = s3 / (1.f + __expf(-(v.w + bb.w)));
            u32x2 o; o.x = pk2(o0, o1); o.y = pk2(o2, o3);
            *(u32x2*)(ss2 + (size_t)row * 512 + col) = o;
          }
      }
  }
};
struct EpiRes {
  const float* xp; const float* xs; float* xcur; int from_in;
  DI void operator()(const f32x4 (&acc)[2][2][4][2], int pm, int pn, int wr, int wc, int fr, int fq, char*, bool atomic) const {
#pragma unroll
    for (int ai = 0; ai < 2; ++ai)
#pragma unroll
      for (int m = 0; m < 4; ++m) {
        const int row = pm * 256 + ai * 128 + wr * 64 + m * 16 + fr;
        const float* src = from_in ? (row < MP ? xp + (size_t)row * 1024 : xs + (size_t)(row - MP) * 1024) : xcur + (size_t)row * 1024;
        asm volatile("" ::: "memory");
#pragma unroll
        for (int bj = 0; bj < 2; ++bj)
#pragma unroll
          for (int n = 0; n < 2; ++n) {
            const int col = pn * 256 + bj * 128 + wc * 32 + n * 16 + fq * 4;
            if (atomic) {
              float* d = xcur + (size_t)row * 1024 + col; const f32x4 v = acc[ai][bj][m][n];
              unsafeAtomicAdd(d, v.x); unsafeAtomicAdd(d + 1, v.y); unsafeAtomicAdd(d + 2, v.z); unsafeAtomicAdd(d + 3, v.w);
            } else {
              const f32x4 x = *(const f32x4*)(src + col);
              *(f32x4*)(xcur + (size_t)row * 1024 + col) = x + acc[ai][bj][m][n];
            }
          }
      }
  }
};
struct EpiUp {
  int l; bf16_t* act; float* halo; float* ups; const float* conv_w; const float* conv_b; float* out;
  DI void operator()(const f32x4 (&acc)[2][2][4][2], int pm, int pn, int wr, int wc, int fr, int fq, char* shm, bool atomic) const {
    const int chb = pn * 128;
    if (pm >= 128) {
#pragma unroll
      for (int ai = 0; ai < 2; ++ai)
#pragma unroll
        for (int m = 0; m < 4; ++m) {
          const int rs = (pm - 128) * 256 + ai * 128 + wr * 64 + m * 16 + fr;
#pragma unroll
          for (int bj = 0; bj < 2; ++bj)
#pragma unroll
            for (int n = 0; n < 2; ++n) {
              const int c = wc * 32 + n * 16 + fq * 4;
              *(f32x4*)(ups + (size_t)rs * 5376 + (bj ? 2688 : 0) + chb + c) = acc[ai][bj][m][n];
            }
        }
      return;
    }
    bf16_t* S = (bf16_t*)shm;
#pragma unroll
    for (int ai = 0; ai < 2; ++ai)
#pragma unroll
      for (int m = 0; m < 4; ++m) {
        const int R = ai * 128 + wr * 64 + m * 16 + fr;
#pragma unroll
        for (int bj = 0; bj < 2; ++bj)
#pragma unroll
          for (int n = 0; n < 2; ++n) {
            const int c = wc * 32 + n * 16 + fq * 4;
            const f32x4 v = acc[ai][bj][m][n];
            u32x2 o; o.x = pk2(v.x, v.y); o.y = pk2(v.z, v.w);
            *(u32x2*)(S + R * 264 + bj * 128 + c) = o;
            if (((ai == 0 && m == 0) || (ai == 1 && m == 3)) && (R < 2 || R >= 254)) {
              const int hr = R < 2 ? R : R - 252;
              const int oc = (bj ? 2688 : 0) + chb + c;
              *(f32x4*)(halo + ((size_t)(pm * 4 + hr)) * 5376 + oc) = v;
              if (R >= 254 && (pm & 15) == 15) *(f32x4*)(out + O_CP + ((size_t)((l * 8 + (pm >> 4)) * 2 + (R - 254))) * 5376 + oc) = v;
            }
          }
      }
    __syncthreads();
    {
      const int tid = tid_opq(); const int cg8 = (tid & 15) * 8, rbase = tid >> 4;
      const float* cw = conv_w + (size_t)l * 3 * 5376;
      const float* cb = conv_b + (size_t)l * 5376;
      float wa[3][8], wg[3][8], ba[8], bg[8];
#pragma unroll
      for (int i = 0; i < 3; ++i) {
        const f32x4 a0 = *(const f32x4*)(cw + i * 5376 + chb + cg8), a1 = *(const f32x4*)(cw + i * 5376 + chb + cg8 + 4);
        const f32x4 g0 = *(const f32x4*)(cw + i * 5376 + 2688 + chb + cg8), g1 = *(const f32x4*)(cw + i * 5376 + 2688 + chb + cg8 + 4);
        wa[i][0] = a0.x; wa[i][1] = a0.y; wa[i][2] = a0.z; wa[i][3] = a0.w; wa[i][4] = a1.x; wa[i][5] = a1.y; wa[i][6] = a1.z; wa[i][7] = a1.w;
        wg[i][0] = g0.x; wg[i][1] = g0.y; wg[i][2] = g0.z; wg[i][3] = g0.w; wg[i][4] = g1.x; wg[i][5] = g1.y; wg[i][6] = g1.z; wg[i][7] = g1.w;
      }
      {
        const f32x4 a0 = *(const f32x4*)(cb + chb + cg8), a1 = *(const f32x4*)(cb + chb + cg8 + 4);
        const f32x4 g0 = *(const f32x4*)(cb + 2688 + chb + cg8), g1 = *(const f32x4*)(cb + 2688 + chb + cg8 + 4);
        ba[0] = a0.x; ba[1] = a0.y; ba[2] = a0.z; ba[3] = a0.w; ba[4] = a1.x; ba[5] = a1.y; ba[6] = a1.z; ba[7] = a1.w;
        bg[0] = g0.x; bg[1] = g0.y; bg[2] = g0.z; bg[3] = g0.w; bg[4] = g1.x; bg[5] = g1.y; bg[6] = g1.z; bg[7] = g1.w;
      }
#pragma unroll 1
      for (int i = 0; i < 8; ++i) {
        const int R = rbase + 32 * i;
        if (R < 2) continue;
        u32x4 av[3], gv[3];
#pragma unroll
        for (int d = 0; d < 3; ++d) { av[d] = *(const u32x4*)(S + (R - 2 + d) * 264 + cg8); gv[d] = *(const u32x4*)(S + (R - 2 + d) * 264 + 128 + cg8); }
        float res[8];
#pragma unroll
        for (int e = 0; e < 8; ++e) {
          float ca = ba[e], cgv = bg[e];
#pragma unroll
          for (int d = 0; d < 3; ++d) {
            const unsigned aw = av[d][e >> 1], gw = gv[d][e >> 1];
            const float af = (e & 1) ? bfhi(aw) : bflo(aw), gf = (e & 1) ? bfhi(gw) : bflo(gw);
            ca += wa[d][e] * af; cgv += wg[d][e] * gf;
          }
          res[e] = ca * cgv / (1.f + __expf(-cgv));
        }
        u32x4 o; o.x = pk2(res[0], res[1]); o.y = pk2(res[2], res[3]); o.z = pk2(res[4], res[5]); o.w = pk2(res[6], res[7]);
        *(u32x4*)(act + (size_t)(pm * 256 + R) * 2688 + chb + cg8) = o;
      }
    }
    __syncthreads();
  }
};

DI float conv_act(float a0, float a1, float a2, float g0, float g1, float g2, const float* cw, const float* cb, int ch) {
  const float ca = cb[ch] + cw[ch] * a0 + cw[5376 + ch] * a1 + cw[2 * 5376 + ch] * a2;
  const float cgv = cb[2688 + ch] + cw[2688 + ch] * g0 + cw[5376 + 2688 + ch] * g1 + cw[2 * 5376 + 2688 + ch] * g2;
  return ca * cgv / (1.f + __expf(-cgv));
}
DI void fixup_phase(CParams& P, int l) {
  const float* halo = (const float*)(P.ws + WS_HALO);
  const float* ups = (const float*)(P.ws + WS_UPS);
  bf16_t* act = (bf16_t*)(P.ws + WS_ACT);
  const float* cw = P.in[25] + (size_t)l * 3 * 5376;
  const float* cb = P.in[26] + (size_t)l * 5376;
  const float* sconv = P.in[6] + (size_t)l * 128 * 2 * 5376;
  const int gt = blockIdx.x * 512 + tid_opq(), nthr = gridDim.x * 512;
  for (int idx = gt; idx < 128 * 2 * 2688; idx += nthr) {
    const int ch = idx % 2688, i = (idx / 2688) & 1, pm = idx / (2 * 2688);
    const bool first = (pm & 15) == 0;
    const float* cur = halo + (size_t)(pm * 4 + i) * 5376;
    const float* p1 = i == 1 ? halo + (size_t)(pm * 4 + 0) * 5376 : halo + (size_t)((pm - 1) * 4 + 3) * 5376;
    const float* p2 = i == 1 ? halo + (size_t)((pm - 1) * 4 + 3) * 5376 : halo + (size_t)((pm - 1) * 4 + 2) * 5376;
    const bool v1 = (i == 1) || !first, v2 = !first;
    const float a2 = cur[ch], g2 = cur[2688 + ch];
    const float a1 = v1 ? p1[ch] : 0.f, g1 = v1 ? p1[2688 + ch] : 0.f;
    const float a0 = v2 ? p2[ch] : 0.f, g0 = v2 ? p2[2688 + ch] : 0.f;
    const float r = conv_act(a0, a1, a2, g0, g1, g2, cw, cb, ch);
    act[(size_t)(pm * 256 + i) * 2688 + ch] = (bf16_t)(pk2(r, 0.f) & 0xffffu);
  }
  for (int idx = gt; idx < 512 * 2688; idx += nthr) {
    const int ch = idx % 2688, rs = idx / 2688, b = rs >> 2, t = rs & 3;
    const float* cur = ups + (size_t)rs * 5376;
    const float* sc = sconv + (size_t)b * 2 * 5376;
    const float* p1 = t >= 1 ? cur - 5376 : sc + 5376;
    const float* p2 = t >= 2 ? cur - 2 * 5376 : sc + (size_t)t * 5376;
    const float a2 = cur[ch], g2 = cur[2688 + ch];
    const float r = conv_act(p2[ch], p1[ch], a2, p2[2688 + ch], p1[2688 + ch], g2, cw, cb, ch);
    act[(size_t)(MP + rs) * 2688 + ch] = (bf16_t)(pk2(r, 0.f) & 0xffffu);
    if (t >= 2) {
      float* o = P.out + O_CS + ((size_t)((l * 128 + b) * 2 + (t - 2))) * 5376;
      o[ch] = a2; o[2688 + ch] = g2;
    }
  }
}

DI void attn_prompt_unit(CParams& P, int l, int unit, char* shm) {
  const int tid = tid_opq(); const int wid = tid >> 6, lane = tid & 63, fr = lane & 15, fq = lane >> 4;
  const int kvh = unit & 1, qb = (unit >> 1) & 31, b = unit >> 6;
  const bf16_t* qkv = (const bf16_t*)(P.ws + WS_QKV);
  bf16_t* attn = (bf16_t*)(P.ws + WS_ATT);
  bf16_t* Ks = (bf16_t*)shm;
  bf16_t* Vt = (bf16_t*)(shm + 36864);
#pragma unroll
  for (int p = 0; p < 4; ++p) {
    const int key = p * 64 + (tid >> 3), seg = tid & 7, kpos = qb * 128 - 128 + key;
    u32x4 v = (u32x4){0u, 0u, 0u, 0u};
    if (kpos >= 0) v = *(const u32x4*)(qkv + (size_t)(b * 4096 + kpos) * 768 + 512 + kvh * 64 + seg * 8);
    *(u32x4*)(Ks + key * 72 + seg * 8) = v;
  }
#pragma unroll
  for (int p = 0; p < 4; ++p) {
    const int key = p * 64 + (tid & 63), seg = tid >> 6, kpos = qb * 128 - 128 + key;
    u32x4 v = (u32x4){0u, 0u, 0u, 0u};
    if (kpos >= 0) v = *(const u32x4*)(qkv + (size_t)(b * 4096 + kpos) * 768 + 640 + kvh * 64 + seg * 8);
#pragma unroll
    for (int e = 0; e < 4; ++e) {
      Vt[(seg * 8 + 2 * e) * 264 + key] = (bf16_t)(v[e] & 0xffffu);
      Vt[(seg * 8 + 2 * e + 1) * 264 + key] = (bf16_t)(v[e] >> 16);
    }
  }
  __syncthreads();
  const int hh = wid >> 1, half = wid & 1, head = kvh * 4 + hh, q0l = half * 64;
  const float slope2 = exp2f(-(float)(head + 1)) * LOG2E;
  const float sink2 = P.in[9][l * 8 + head] * LOG2E;
  const float scale2 = 0.125f * LOG2E;
  bf16x8 qf[4][2];
#pragma unroll
  for (int qt = 0; qt < 4; ++qt)
#pragma unroll
    for (int kk = 0; kk < 2; ++kk)
      qf[qt][kk] = *(const bf16x8*)(qkv + (size_t)(b * 4096 + qb * 128 + q0l + qt * 16 + fr) * 768 + head * 64 + kk * 32 + fq * 8);
  float mrow[4], lsum[4];
  f32x4 o[4][4];
#pragma unroll
  for (int qt = 0; qt < 4; ++qt) {
    mrow[qt] = sink2; lsum[qt] = fq == 0 ? 1.f : 0.f;
#pragma unroll
    for (int dt = 0; dt < 4; ++dt) o[dt][qt] = (f32x4){0.f, 0.f, 0.f, 0.f};
  }
  for (int kt = 0; kt < 3; ++kt) {
    const int klb = q0l + kt * 64;
    f32x4 s[4][4];
#pragma unroll
    for (int ks = 0; ks < 4; ++ks) {
      const bf16x8 kf0 = *(const bf16x8*)(Ks + (klb + ks * 16 + fr) * 72 + fq * 8);
      const bf16x8 kf1 = *(const bf16x8*)(Ks + (klb + ks * 16 + fr) * 72 + 32 + fq * 8);
#pragma unroll
      for (int qt = 0; qt < 4; ++qt) {
        f32x4 z = (f32x4){0.f, 0.f, 0.f, 0.f};
        z = MFMA16(kf0, qf[qt][0], z);
        s[ks][qt] = MFMA16(kf1, qf[qt][1], z);
      }
    }
    bf16x8 pf[4][2];
#pragma unroll
    for (int qt = 0; qt < 4; ++qt) {
      const int qloc = q0l + qt * 16 + fr;
      float mx = -3.0e38f;
#pragma unroll
      for (int ks = 0; ks < 4; ++ks)
#pragma unroll
        for (int j = 0; j < 4; ++j) {
          const int kl = klb + ks * 16 + fq * 4 + j;
          const int dist = qloc + 128 - kl;
          const bool valid = dist >= 0 && dist < 128 && (qb > 0 || kl >= 128);
          const float val = valid ? s[ks][qt][j] * scale2 - slope2 * (float)dist : -1.0e30f;
          s[ks][qt][j] = val;
          mx = fmaxf(mx, val);
        }
      mx = fmaxf(mx, shx(mx, 16, lane));
      mx = fmaxf(mx, shx(mx, 32, lane));
      const float mnew = fmaxf(mrow[qt], mx);
      const float alpha = exp2f(mrow[qt] - mnew);
      mrow[qt] = mnew;
      float psum = 0.f;
#pragma unroll
      for (int ks = 0; ks < 4; ++ks)
#pragma unroll
        for (int j = 0; j < 4; ++j) { const float pv = exp2f(s[ks][qt][j] - mnew); s[ks][qt][j] = pv; psum += pv; }
      lsum[qt] = lsum[qt] * alpha + psum;
#pragma unroll
      for (int dt = 0; dt < 4; ++dt) o[dt][qt] = o[dt][qt] * alpha;
#pragma unroll
      for (int ksp = 0; ksp < 2; ++ksp) {
        u32x4 pw;
        pw.x = pk2(s[2 * ksp][qt][0], s[2 * ksp][qt][1]); pw.y = pk2(s[2 * ksp][qt][2], s[2 * ksp][qt][3]);
        pw.z = pk2(s[2 * ksp + 1][qt][0], s[2 * ksp + 1][qt][1]); pw.w = pk2(s[2 * ksp + 1][qt][2], s[2 * ksp + 1][qt][3]);
        pf[qt][ksp] = as_bf16x8(pw);
      }
    }
#pragma unroll
    for (int ksp = 0; ksp < 2; ++ksp)
#pragma unroll
      for (int dt = 0; dt < 4; ++dt) {
        const u32x2 v0 = *(const u32x2*)(Vt + (dt * 16 + fr) * 264 + klb + (2 * ksp) * 16 + fq * 4);
        const u32x2 v1 = *(const u32x2*)(Vt + (dt * 16 + fr) * 264 + klb + (2 * ksp + 1) * 16 + fq * 4);
        const bf16x8 vf = as_bf16x8((u32x4){v0.x, v0.y, v1.x, v1.y});
#pragma unroll
        for (int qt = 0; qt < 4; ++qt) o[dt][qt] = MFMA16(vf, pf[qt][ksp], o[dt][qt]);
      }
  }
#pragma unroll
  for (int qt = 0; qt < 4; ++qt) {
    float lt = lsum[qt];
    lt += shx(lt, 16, lane); lt += shx(lt, 32, lane);
    const float inv = 1.f / lt;
    const size_t row = (size_t)(b * 4096 + qb * 128 + q0l + qt * 16 + fr);
#pragma unroll
    for (int dt = 0; dt < 4; ++dt) {
      const f32x4 v = o[dt][qt] * inv;
      u32x2 ov; ov.x = pk2(v.x, v.y); ov.y = pk2(v.z, v.w);
      *(u32x2*)(attn + row * 512 + head * 64 + dt * 16 + fq * 4) = ov;
    }
  }
  __syncthreads();
}

DI void attn_sample_unit(CParams& P, int l, int unit, char* shm) {
  const int tid = tid_opq();
  const int kvh = unit & 1, b = unit >> 1;
  const bf16_t* qkv = (const bf16_t*)(P.ws + WS_QKV);
  bf16_t* attn = (bf16_t*)(P.ws + WS_ATT);
  float* Ksf = (float*)shm;
  float* Vsf = Ksf + 132 * 65;
  float* Qsf = Vsf + 132 * 65;
  float* Ps = Qsf + 16 * 64;
  const float* ck = P.in[2] + (size_t)(l * 128 + b) * 128 * 128;
  const float* cv = P.in[3] + (size_t)(l * 128 + b) * 128 * 128;
  float* okw = P.out + O_KS + (size_t)(l * 128 + b) * 128 * 128;
  float* ovw = P.out + O_VS + (size_t)(l * 128 + b) * 128 * 128;
#pragma unroll 4
  for (int i = 0; i < 16; ++i) {
    const int idx = tid + 512 * i, key = idx >> 6, d = idx & 63;
    const float kv = ck[key * 128 + kvh * 64 + d], vv = cv[key * 128 + kvh * 64 + d];
    Ksf[key * 65 + d] = kv; Vsf[key * 65 + d] = vv;
    if (key >= 4) { okw[(key - 4) * 128 + kvh * 64 + d] = kv; ovw[(key - 4) * 128 + kvh * 64 + d] = vv; }
  }
  if (tid < 256) {
    const int t = tid >> 6, d = tid & 63; const size_t row = (size_t)(MP + b * 4 + t);
    Ksf[(128 + t) * 65 + d] = bf2f(qkv[row * 768 + 512 + kvh * 64 + d]);
    Vsf[(128 + t) * 65 + d] = bf2f(qkv[row * 768 + 640 + kvh * 64 + d]);
  }
#pragma unroll
  for (int i = 0; i < 2; ++i) {
    const int idx = tid + 512 * i, rq = idx >> 6, d = idx & 63, hh = rq >> 2, t = rq & 3;
    Qsf[rq * 64 + d] = bf2f(qkv[(size_t)(MP + b * 4 + t) * 768 + (kvh * 4 + hh) * 64 + d]);
  }
  __syncthreads();
  const int rq = tid >> 5, kl = tid & 31, hh = rq >> 2, t = rq & 3, head = kvh * 4 + hh;
  {
    const float slope = exp2f(-(float)(head + 1));
    const float sink = P.in[9][l * 8 + head];
    float sc[5]; float mx = sink;
#pragma unroll
    for (int i = 0; i < 5; ++i) {
      const int key = kl + 32 * i;
      float val = -1.0e30f;
      if (key < 132) {
        float dot = 0.f;
#pragma unroll 8
        for (int d = 0; d < 64; ++d) dot += Qsf[rq * 64 + d] * Ksf[key * 65 + d];
        const int dist = key < 128 ? (t + 128 - key) : (t - (key - 128));
        if (dist >= 0 && dist < 128) val = dot * 0.125f - slope * (float)dist;
      }
      sc[i] = val; mx = fmaxf(mx, val);
    }
#pragma unroll
    for (int o = 1; o < 32; o <<= 1) mx = fmaxf(mx, shx(mx, o, tid & 63));
    float sum = 0.f;
#pragma unroll
    for (int i = 0; i < 5; ++i) { sc[i] = __expf(sc[i] - mx); sum += sc[i]; }
#pragma unroll
    for (int o = 1; o < 32; o <<= 1) sum += shx(sum, o, tid & 63);
    sum += __expf(sink - mx);
    const float inv = 1.f / sum;
#pragma unroll
    for (int i = 0; i < 5; ++i) { const int key = kl + 32 * i; if (key < 132) Ps[rq * 136 + key] = sc[i] * inv; }
  }
  __syncthreads();
  {
    float a0 = 0.f, a1 = 0.f;
#pragma unroll 4
    for (int key = 0; key < 132; ++key) { const float p = Ps[rq * 136 + key]; a0 += p * Vsf[key * 65 + kl]; a1 += p * Vsf[key * 65 + kl + 32]; }
    const size_t row = (size_t)(MP + b * 4 + t);
    attn[row * 512 + head * 64 + kl] = (bf16_t)(pk2(a0, 0.f) & 0xffffu);
    attn[row * 512 + head * 64 + kl + 32] = (bf16_t)(pk2(a1, 0.f) & 0xffffu);
  }
  __syncthreads();
}

DI void sincos_rev(double ang, float& s, float& c) {
  double r = ang * 0.15915494309189535;
  r -= __builtin_rint(r);
  const float x = (float)(r * 6.283185307179586);
  s = sinf(x); c = cosf(x);
}
DI void s5_item(CParams& P, int l, int mode, int item, char* wl, int lane) {
  int b, c, g;
  g = item & 31;
  if (mode == 2) { b = item >> 5; c = 0; } else { c = (item >> 5) & 7; b = item >> 8; }
  const int n = lane, fr = lane & 15, fq = lane >> 4;
  const int gi = (l * 32 + g) * 64 + n;
  const float lr = P.in[10][gi], li = P.in[11][gi];
  const float dt = expf(P.in[12][l * 32 + g]);
  float lbr, lbi;
  {
    const float mag = expf(lr * dt); float sn, cs; sincos_rev((double)li * (double)dt, sn, cs);
    lbr = mag * cs; lbi = mag * sn;
  }
  float bbr[16], bbi[16];
  {
    const float den = 1.f / (lr * lr + li * li);
    const float e1 = lbr - 1.f;
    const float qr = (e1 * lr + lbi * li) * den, qi = (lbi * lr - e1 * li) * den;
    const float* br = P.in[13] + (size_t)gi * 16; const float* bi = P.in[14] + (size_t)gi * 16;
#pragma unroll
    for (int q = 0; q < 4; ++q) {
      const f32x4 r4 = *(const f32x4*)(br + 4 * q), i4 = *(const f32x4*)(bi + 4 * q);
#pragma unroll
      for (int e = 0; e < 4; ++e) { bbr[4 * q + e] = qr * r4[e] - qi * i4[e]; bbi[4 * q + e] = qr * i4[e] + qi * r4[e]; }
    }
  }
  float sr = 0.f, si = 0.f;
  float* ends = (float*)(P.ws + WS_ENDS);
  if (mode == 2) { const size_t o = ((size_t)(l * 128 + b) * 32 + g) * 64 + n; sr = P.in[4][o]; si = P.in[5][o]; }
  else if (mode == 1 && c > 0) {
    float pr, pi;
    { const float mag = expf(lr * dt * 512.f); float sn, cs; sincos_rev((double)li * (double)dt * 512.0, sn, cs); pr = mag * cs; pi = mag * sn; }
    for (int c2 = 0; c2 < c; ++c2) {
      const float* e = ends + ((size_t)((b * 8 + c2) * 32 + g) * 64 + n) * 2;
      const float er = e[0], ei = e[1];
      const float nr = pr * sr - pi * si + er, ni = pr * si + pi * sr + ei;
      sr = nr; si = ni;
    }
  }
  const int ntok = mode == 2 ? 4 : 512;
  const size_t row0 = mode == 2 ? (size_t)(MP + b * 4) : (size_t)(b * 4096 + c * 512);
  const float* U = (const float*)(P.ws + WS_U);
  bf16_t* ssr = (bf16_t*)(P.ws + WS_SSR);
  float* ul = (float*)wl;
  unsigned* Sl = (unsigned*)(wl + 2048);
  bf16x8 cfrag[4]; f32x4 dsk = (f32x4){0.f, 0.f, 0.f, 0.f};
  if (mode >= 1) {
#pragma unroll
    for (int kk = 0; kk < 4; ++kk) {
      const size_t o = ((size_t)(l * 32 + g) * 16 + fr) * 64 + kk * 16 + fq * 4;
      const f32x4 cr = *(const f32x4*)(P.in[15] + o), ci = *(const f32x4*)(P.in[16] + o);
      u32x4 w; w.x = pk2(cr.x, -ci.x); w.y = pk2(cr.y, -ci.y); w.z = pk2(cr.z, -ci.z); w.w = pk2(cr.w, -ci.w);
      cfrag[kk] = as_bf16x8(w);
    }
    dsk = *(const f32x4*)(P.in[17] + l * 512 + g * 16 + fq * 4);
  } else {
#pragma unroll
    for (int kk = 0; kk < 4; ++kk) cfrag[kk] = as_bf16x8((u32x4){0u, 0u, 0u, 0u});
  }
  const int nsub = (ntok + 15) >> 4;
  f32x4 upre = (f32x4){0.f, 0.f, 0.f, 0.f};
  { const int tok = lane >> 2, seg = lane & 3; if (tok < ntok) upre = *(const f32x4*)(U + (row0 + tok) * 512 + g * 16 + seg * 4); }
  for (int sub = 0; sub < nsub; ++sub) {
    float* uc = ul + (sub & 1) * 256;
    *(f32x4*)(uc + lane * 4) = upre;
    if (sub + 1 < nsub) { const int tok = (sub + 1) * 16 + (lane >> 2), seg = lane & 3; upre = *(const f32x4*)(U + (row0 + tok) * 512 + g * 16 + seg * 4); }
    const int tmax = ntok - sub * 16 < 16 ? ntok - sub * 16 : 16;
#pragma unroll 4
    for (int tt = 0; tt < 16; ++tt) {
      if (tt < tmax) {
        const f32x4 u0 = *(const f32x4*)(uc + tt * 16), u1 = *(const f32x4*)(uc + tt * 16 + 4), u2 = *(const f32x4*)(uc + tt * 16 + 8), u3 = *(const f32x4*)(uc + tt * 16 + 12);
        float bur = 0.f, bui = 0.f;
#pragma unroll
        for (int e = 0; e < 4; ++e) {
          bur += u0[e] * bbr[e]; bui += u0[e] * bbi[e];
          bur += u1[e] * bbr[4 + e]; bui += u1[e] * bbi[4 + e];
          bur += u2[e] * bbr[8 + e]; bui += u2[e] * bbi[8 + e];
          bur += u3[e] * bbr[12 + e]; bui += u3[e] * bbi[12 + e];
        }
        const float nr = lbr * sr - lbi * si + bur, ni = lbr * si + lbi * sr + bui;
        sr = nr; si = ni;
        if (mode >= 1) Sl[tt * 68 + n] = pk2(sr, si);
      }
    }
    if (mode >= 1) {
      f32x4 acc = (f32x4){0.f, 0.f, 0.f, 0.f};
#pragma unroll
      for (int kk = 0; kk < 4; ++kk) {
        const u32x4 sv = *(const u32x4*)(Sl + fr * 68 + kk * 16 + fq * 4);
        acc = MFMA16(cfrag[kk], as_bf16x8(sv), acc);
      }
      if (fr < tmax) {
        const f32x4 u4 = *(const f32x4*)(uc + fr * 16 + fq * 4);
        float y[4];
#pragma unroll
        for (int j = 0; j < 4; ++j) {
          const float x = acc[j] + dsk[j] * u4[j];
          const float z2 = 1.5957691216057308f * (x + 0.044715f * x * x * x);
          y[j] = x / (1.f + __expf(-z2));
        }
        u32x2 ov; ov.x = pk2(y[0], y[1]); ov.y = pk2(y[2], y[3]);
        *(u32x2*)(ssr + (row0 + sub * 16 + fr) * 512 + g * 16 + fq * 4) = ov;
      }
    }
  }
  if (mode == 0) { float* e = ends + ((size_t)((b * 8 + c) * 32 + g) * 64 + n) * 2; e[0] = sr; e[1] = si; }
  else if (mode == 1) { if (c == 7) { const size_t o = ((size_t)(l * 8 + b) * 32 + g) * 64 + n; P.out[O_RP + o] = sr; P.out[O_IP + o] = si; } }
  else { const size_t o = ((size_t)(l * 128 + b) * 32 + g) * 64 + n; P.out[O_RS + o] = sr; P.out[O_IS + o] = si; }
}

DI void merge_phase(CParams& P, int l) {
  const int tid = tid_opq(); const int wid = tid >> 6, lane = tid & 63;
  const bf16_t* attn = (const bf16_t*)(P.ws + WS_ATT);
  const bf16_t* ss2 = (const bf16_t*)(P.ws + WS_SS2);
  bf16_t* h = (bf16_t*)(P.ws + WS_H);
  const float* ga = P.in[20] + l * 512 + lane * 8;
  const float* gs = P.in[21] + l * 512 + lane * 8;
  const f32x4 ga0 = *(const f32x4*)ga, ga1 = *(const f32x4*)(ga + 4), gs0 = *(const f32x4*)gs, gs1 = *(const f32x4*)(gs + 4);
  for (int r = blockIdx.x * 8 + wid; r < MT; r += gridDim.x * 8) {
    const u32x4 av = *(const u32x4*)(attn + (size_t)r * 512 + lane * 8);
    const u32x4 sv = *(const u32x4*)(ss2 + (size_t)r * 512 + lane * 8);
    float a[8], s[8]; float qa = 0.f, qs = 0.f;
#pragma unroll
    for (int e = 0; e < 4; ++e) { a[2 * e] = bflo(av[e]); a[2 * e + 1] = bfhi(av[e]); s[2 * e] = bflo(sv[e]); s[2 * e + 1] = bfhi(sv[e]); }
#pragma unroll
    for (int e = 0; e < 8; ++e) { qa += a[e] * a[e]; qs += s[e] * s[e]; }
    qa = wave_sum(qa, lane); qs = wave_sum(qs, lane);
    const float ra = rsqrtf(qa * (1.f / 512.f) + EPS), rs = rsqrtf(qs * (1.f / 512.f) + EPS);
    u32x4 oa, os;
    oa.x = pk2(a[0] * ra * ga0.x, a[1] * ra * ga0.y); oa.y = pk2(a[2] * ra * ga0.z, a[3] * ra * ga0.w);
    oa.z = pk2(a[4] * ra * ga1.x, a[5] * ra * ga1.y); oa.w = pk2(a[6] * ra * ga1.z, a[7] * ra * ga1.w);
    os.x = pk2(s[0] * rs * gs0.x, s[1] * rs * gs0.y); os.y = pk2(s[2] * rs * gs0.z, s[3] * rs * gs0.w);
    os.z = pk2(s[4] * rs * gs1.x, s[5] * rs * gs1.y); os.w = pk2(s[6] * rs * gs1.z, s[7] * rs * gs1.w);
    *(u32x4*)(h + (size_t)r * 1024 + lane * 8) = oa;
    *(u32x4*)(h + (size_t)r * 1024 + 512 + lane * 8) = os;
    if (l == 0 && r >= MP) {
      const f32x4* xs = (const f32x4*)(P.in[1] + (size_t)(r - MP) * 1024);
      f32x4* xd = (f32x4*)((float*)(P.ws + WS_X) + (size_t)r * 1024);
#pragma unroll
      for (int j = 0; j < 4; ++j) xd[lane + 64 * j] = xs[lane + 64 * j];
    }
  }
}

#define XB_TMO      128
#define XB_XCNT(j)  (256  + 64 * (j))
#define XB_XSUB(j)  (1280 + 64 * (j))
#define XB_XGEN(j)  (2304 + 64 * (j))
#define XB_TOP      3328
#define XB_TOPGEN   3392
#define XCD_BAR_WORDS 3456
#define XB_SPIN_CAP (1u << 18)
#define LAS __attribute__((address_space(3)))
DI unsigned xb_ld(unsigned* p)              { return __hip_atomic_load(p, __ATOMIC_RELAXED, __HIP_MEMORY_SCOPE_AGENT); }
DI unsigned xb_add(unsigned* p, unsigned v) { return __hip_atomic_fetch_add(p, v, __ATOMIC_RELAXED, __HIP_MEMORY_SCOPE_AGENT); }
DI unsigned xb_xcc_id() { return (unsigned)__builtin_amdgcn_s_getreg((3 << 11) | 20) & 0xFu; }
#define XB_SPIN(cond, bar) do { unsigned _sp = 0; while (cond) { __builtin_amdgcn_s_sleep(1); \
    if ((++_sp & 255u) == 0u) { if (xb_ld(&(bar)[XB_TMO])) break; if (_sp > XB_SPIN_CAP) { atomicAdd(&(bar)[XB_TMO], 1u); break; } } } } while (0)
struct XcdBarrier { unsigned* bar; unsigned x; volatile LAS unsigned* st; };
DI XcdBarrier xcd_barrier_post(unsigned* bar, volatile LAS unsigned* st) {
  XcdBarrier b; b.bar = bar; b.x = xb_xcc_id(); b.st = st;
  if (threadIdx.x == 0) (void)xb_add(&bar[XB_XCNT(b.x)], 1u);
  return b;
}
DI void xcd_barrier_complete(unsigned* bar, unsigned x, unsigned& nloc, unsigned& nx) {
  const unsigned G = gridDim.x * gridDim.y * gridDim.z;
  unsigned sum, cnt, mine, sp = 0u;
  for (;;) {
    sum = 0u; cnt = 0u; mine = 0u;
#pragma unroll
    for (unsigned j = 0; j < 16; ++j) { const unsigned c = xb_ld(&bar[XB_XCNT(j)]); sum += c; cnt += (c > 0u) ? 1u : 0u; mine = (j == x) ? c : mine; }
    if (sum == G) break;
    __builtin_amdgcn_s_sleep(1);
    if ((++sp & 255u) == 0u) { if (xb_ld(&bar[XB_TMO])) break; if (sp > XB_SPIN_CAP) { atomicAdd(&bar[XB_TMO], 1u); break; } }
  }
  nloc = mine > 0u ? mine : 1u; nx = cnt > 0u ? cnt : 1u;
}
DI void xcd_barrier(const XcdBarrier& b) {
  asm volatile("s_waitcnt vmcnt(0)" ::: "memory");
  __syncthreads();
  if (threadIdx.x == 0) {
    unsigned* bar = b.bar;
    __builtin_amdgcn_s_waitcnt(0);
    unsigned nloc = b.st[0], nx = b.st[1];
    if (nloc == 0u) { xcd_barrier_complete(bar, b.x, nloc, nx); b.st[0] = nloc; b.st[1] = nx; }
    const unsigned old = xb_add(&bar[XB_XSUB(b.x)], 1u);
    const unsigned gen = old / nloc;
    if (old + 1u == (gen + 1u) * nloc) {
      __builtin_amdgcn_fence(__ATOMIC_RELEASE, "agent");
      asm volatile("s_waitcnt vmcnt(0)" ::: "memory");
      const unsigned og = xb_add(&bar[XB_TOP], 1u);
      const unsigned tg = og / nx;
      if (og + 1u == (tg + 1u) * nx) xb_add(&bar[XB_TOPGEN], 1u);
      else XB_SPIN(xb_ld(&bar[XB_TOPGEN]) == tg, bar);
      __builtin_amdgcn_fence(__ATOMIC_ACQUIRE, "agent");
      xb_add(&bar[XB_XGEN(b.x)], 1u);
      asm volatile("s_waitcnt vmcnt(0)" ::: "memory");
    } else {
      XB_SPIN(xb_ld(&bar[XB_XGEN(b.x)]) == gen, bar);
      __builtin_amdgcn_fence(__ATOMIC_ACQUIRE, "agent");
      asm volatile("s_waitcnt vmcnt(0)" ::: "memory");
    }
  }
  __syncthreads();
}

#ifndef SKIP_MASK
#define SKIP_MASK 0
#endif
#ifndef DOUBLE_MASK
#define DOUBLE_MASK 0
#endif
#define PH(x) for (int rep_ = 0; rep_ < (((DOUBLE_MASK >> (x)) & 1) ? 2 : 1); ++rep_) if constexpr (!((SKIP_MASK >> (x)) & 1))
#define GSYNC xcd_barrier(xb)
#ifndef GEMMFN
#define GEMMFN gemm_phase8
#endif
template <int l>
DI void layer_body(CParams* kp, char* shm, const XcdBarrier& xb) {
#define P (*launder(kp))
  const int nblk = gridDim.x;
  bf16_t* wt0 = (bf16_t*)(P.ws + WS_WT);
  bf16_t* hbuf = (bf16_t*)(P.ws + WS_H);
  float* xcur = (float*)(P.ws + WS_X);

    const bf16_t* wt = wt0 + (size_t)l * WT_LAYER;
    PH(1) {
      EpiIn e; e.l = l; e.qkv = (bf16_t*)(P.ws + WS_QKV); e.u = (float*)(P.ws + WS_U); e.out = P.out;
      GEMMFN(hbuf, wt + WT_IN, 130, 5, 1024, e, shm);
    }
    GSYNC;
    {
      PH(2) for (int u = blockIdx.x; u < 512; u += nblk) attn_prompt_unit(P, l, u, shm);
      PH(3) for (int u = blockIdx.x; u < 256; u += nblk) attn_sample_unit(P, l, u, shm);
      const int tq = tid_opq(); const int wv = __builtin_amdgcn_readfirstlane(tq >> 6), lane = tq & 63;
      PH(4) for (int it = blockIdx.x * 8 + wv; it < 2048; it += nblk * 8) s5_item(P, l, 0, it, shm + wv * 6656, lane);
    }
    GSYNC;
    {
      const int tq = tid_opq(); const int wv = __builtin_amdgcn_readfirstlane(tq >> 6), lane = tq & 63;
      PH(5) for (int it = blockIdx.x * 8 + wv; it < 2048; it += nblk * 8) s5_item(P, l, 1, it, shm + wv * 6656, lane);
      PH(6) for (int it = blockIdx.x * 8 + wv; it < 4096; it += nblk * 8) s5_item(P, l, 2, it, shm + wv * 6656, lane);
    }
    GSYNC;
    PH(7) {
      EpiGlu e; e.ssr = (const bf16_t*)(P.ws + WS_SSR); e.ss2 = (bf16_t*)(P.ws + WS_SS2); e.bias = P.in[19] + l * 512;
      GEMMFN((const bf16_t*)(P.ws + WS_SSR), wt + WT_GLU, 130, 2, 512, e, shm);
    }
    GSYNC;
    PH(8) merge_phase(P, l);
    GSYNC;
    PH(9) {
      EpiRes e; e.xp = P.in[0]; e.xs = P.in[1]; e.xcur = xcur; e.from_in = (l == 0);
      GEMMFN(hbuf, wt + WT_OUT, 130, 4, 1024, e, shm, 512, 4);
    }
    GSYNC;
    PH(10) norm_phase(P, 1, P.in[23] + l * 1024);
    GSYNC;
    PH(11) {
      EpiUp e; e.l = l; e.act = (bf16_t*)(P.ws + WS_ACT); e.halo = (float*)(P.ws + WS_HALO); e.ups = (float*)(P.ws + WS_UPS);
      e.conv_w = P.in[25]; e.conv_b = P.in[26]; e.out = P.out;
      GEMMFN(hbuf, wt + WT_UP, 130, 21, 1024, e, shm);
    }
    GSYNC;
    PH(12) fixup_phase(P, l);
    GSYNC;
    PH(13) {
      EpiRes e; e.xp = P.in[0]; e.xs = P.in[1]; e.xcur = xcur; e.from_in = 0;
      GEMMFN((const bf16_t*)(P.ws + WS_ACT), wt + WT_DOWN, 130, 4, 2688, e, shm, 512, 7);
    }
    GSYNC;
    if (l == 0) { norm_phase(P, 1, P.in[7] + 1024); GSYNC; }
    else final_norm_phase(P);
#undef P
}
__global__ void __launch_bounds__(512) mega(Params Parg) {
  extern __shared__ __attribute__((aligned(16))) char shm[];
  CParams* kp = (CParams*)__builtin_amdgcn_kernarg_segment_ptr();
  cg::grid_group grid = cg::this_grid();
  volatile LAS unsigned* xst = (volatile LAS unsigned*)(shm + LDS_BYTES - 16);
  if (threadIdx.x == 0) { xst[0] = 0u; xst[1] = 0u; }
  __syncthreads();
  const XcdBarrier xb = xcd_barrier_post((unsigned*)((*launder(kp)).ws + WS_BAR), xst);
  PH(0) phase0(*launder(kp), shm);
  grid.sync();
  layer_body<0>(kp, shm, xb);
  layer_body<1>(kp, shm, xb);
}
extern "C" void kernel_launch(void* const* d_in, const int* in_sizes, int n_in, void* d_out, int out_size, void* d_ws, size_t ws_size, hipStream_t stream) {
  static int grid_blocks = 0;
  if (grid_blocks == 0) {
    if (n_in != 29 || ws_size < WS_TOTAL) { fprintf(stderr, "kernel_launch: unexpected n_in %d or ws_size %zu (< %zu)\n", n_in, ws_size, (size_t)WS_TOTAL); grid_blocks = -1; return; }
    int dev = 0, cus = 0, per_cu = 0;
    hipGetDevice(&dev);
    hipDeviceGetAttribute(&cus, hipDeviceAttributeMultiprocessorCount, dev);
    hipFuncSetAttribute((const void*)mega, hipFuncAttributeMaxDynamicSharedMemorySize, LDS_BYTES);
    hipOccupancyMaxActiveBlocksPerMultiprocessor(&per_cu, (const void*)mega, 512, LDS_BYTES);
    if (per_cu < 1) per_cu = 1;
    if (per_cu > 1) per_cu = 1;
    grid_blocks = cus * per_cu;
  }
  if (grid_blocks < 0) return;
  Params p{};
  for (int i = 0; i < 29; ++i) p.in[i] = (const float*)d_in[i];
  p.out = (float*)d_out;
  p.ws = (char*)d_ws;
  (void)hipMemsetAsync((char*)d_ws + WS_BAR, 0, XCD_BAR_WORDS * 4, stream);
  void* args[] = {&p};
  hipError_t e = hipLaunchCooperativeKernel((const void*)mega, dim3(grid_blocks), dim3(512), args, LDS_BYTES, stream);
  if (e != hipSuccess) fprintf(stderr, "cooperative launch failed: %s (grid %d)\n", hipGetErrorString(e), grid_blocks);
}
```
